# Optimizing an MI355X kernel written in HIP

```python
import jax, jax.numpy as jnp
from jax import lax
import numpy as np


D_MODEL = 2048
BATCH = 16
SEQ = 2048
DEPTH = 2

CHUNK = 64
EPS = 1e-6
A_BLOCK = 128
A_GROUPS = 4
A_WIDTH = D_MODEL // 2
A_GROUP_DIM = A_WIDTH // A_GROUPS
B_WINDOWS = (2, 4, 8, 16)
B_GROUPS = len(B_WINDOWS)
B_WIDTH = D_MODEL // 2
B_GROUP_DIM = B_WIDTH // B_GROUPS
EVEN_IN = 2 * A_WIDTH + B_WIDTH
EVEN_MIX = A_WIDTH + B_WIDTH
C_HEADS = 16
C_HEAD_DIM = 128
C_WIDTH = C_HEADS * C_HEAD_DIM
Q_BLOCK = 128
ODD_IN = 3 * C_WIDTH + C_HEADS
D_FF = 5632
CONV_WIDTH = 3
N_EVEN = (DEPTH + 1) // 2
N_ODD = DEPTH // 2

kernel_name = 'hybrid_gmlp_pool_fox_encoder'


def rms_norm(x, g):
    x32 = x.astype(jnp.float32)
    y = x32 * lax.rsqrt(jnp.mean(x32 * x32, axis=-1, keepdims=True) + EPS)
    return (y * g.astype(jnp.float32)).astype(x.dtype)


def group_layer_norm(v, g, b):
    v32 = v.astype(jnp.float32)
    mu = jnp.mean(v32, axis=-1, keepdims=True)
    var = jnp.mean(jnp.square(v32 - mu), axis=-1, keepdims=True)
    y = (v32 - mu) * lax.rsqrt(var + EPS) * g.astype(jnp.float32) + b.astype(jnp.float32)
    return y.astype(v.dtype)


def block_causal_mask(n):
    c = jnp.arange(n) // CHUNK
    return c[:, None] >= c[None, :]


def spatial_gating(z, ln_g, ln_b, w_s, b_s):
    bsz, s, _ = z.shape
    u = z[..., :A_WIDTH]
    v = z[..., A_WIDTH:].reshape(bsz, s, A_GROUPS, A_GROUP_DIM)
    v = group_layer_norm(v, ln_g, ln_b)
    v = v.reshape(bsz, s // A_BLOCK, A_BLOCK, A_GROUPS, A_GROUP_DIM)
    w = jnp.where(block_causal_mask(A_BLOCK)[None], w_s, jnp.zeros((), w_s.dtype))
    gate = jnp.einsum('gts,bnsgd->bntgd', w, v) + b_s.T[None, None, :, :, None]
    return u * gate.reshape(bsz, s, A_WIDTH)


def multiscale_pool(p, w_pool, scale):
    bsz, s, _ = p.shape
    p = p.reshape(bsz, s, B_GROUPS, B_GROUP_DIM)
    pos = jnp.arange(s)
    outs = []
    for j, w in enumerate(B_WINDOWS):
        xg = p[:, :, j, :]
        x32 = xg.astype(jnp.float32)
        cs = jnp.cumsum(x32, axis=1)
        lagged = jnp.pad(cs, ((0, 0), (w, 0), (0, 0)))[:, :s]
        count = jnp.minimum(pos + 1, w).astype(jnp.float32)[None, :, None]
        d = ((cs - lagged) / count - x32).astype(p.dtype)
        outs.append(d @ w_pool[j])
    return jnp.concatenate(outs, axis=-1) * scale


def forgetting_attention(q, k, v, log_f):
    bsz, s, h, dh = q.shape
    c = jnp.cumsum(log_f, axis=1).transpose(0, 2, 1)
    scale = dh ** -0.5
    outs = []
    for i in range(s // Q_BLOCK):
        q0 = i * Q_BLOCK
        kl = q0 + Q_BLOCK
        logits = jnp.einsum('bqhd,bkhd->bhqk', q[:, q0:kl], k[:, :kl]).astype(jnp.float32) * scale
        logits = logits + c[:, :, q0:kl, None] - c[:, :, None, :kl]
        causal = (q0 + jnp.arange(Q_BLOCK))[:, None] >= jnp.arange(kl)[None, :]
        logits = jnp.where(causal, logits, -jnp.inf)
        probs = jax.nn.softmax(logits, axis=-1).astype(v.dtype)
        outs.append(jnp.einsum('bhqk,bkhd->bqhd', probs, v[:, :kl]))
    return jnp.concatenate(outs, axis=1)


def conv_ffn(h, w_up, conv_w, conv_b, w_down):
    s = h.shape[1]
    up = h @ w_up
    padded = jnp.pad(up, ((0, 0), (CONV_WIDTH - 1, 0), (0, 0)))
    conv = conv_b
    for j in range(CONV_WIDTH):
        conv = conv + padded[:, j:j + s] * conv_w[j]
    gate, val = conv[..., :D_FF], conv[..., D_FF:]
    return (jax.nn.silu(gate) * val) @ w_down


def setup_inputs(seed: int = 0) -> dict:
    key = jax.random.key(seed)
    ks = jax.random.split(key, 20)
    f32 = jnp.float32

    def nrm(k, shape, scale):
        return jax.random.normal(k, shape, f32) * scale

    return {
        'x': nrm(ks[0], (BATCH, SEQ, D_MODEL), 1.0),
        'norm_mix_g': 1.0 + nrm(ks[1], (DEPTH, D_MODEL), 0.05),
        'norm_ffn_g': 1.0 + nrm(ks[2], (DEPTH, D_MODEL), 0.05),
        'final_norm_g': 1.0 + nrm(ks[3], (D_MODEL,), 0.05),
        'w_in_even': nrm(ks[4], (N_EVEN, D_MODEL, EVEN_IN), D_MODEL ** -0.5),
        'ln_v_g': 1.0 + nrm(ks[5], (N_EVEN, A_GROUPS, A_GROUP_DIM), 0.05),
        'ln_v_b': nrm(ks[6], (N_EVEN, A_GROUPS, A_GROUP_DIM), 0.02),
        'w_spatial': nrm(ks[7], (N_EVEN, A_GROUPS, A_BLOCK, A_BLOCK), A_BLOCK ** -0.5),
        'b_spatial': 1.0 + nrm(ks[8], (N_EVEN, A_GROUPS, A_BLOCK), 0.1),
        'w_pool': nrm(ks[9], (N_EVEN, B_GROUPS, B_GROUP_DIM, B_GROUP_DIM), B_GROUP_DIM ** -0.5),
        'pool_scale': 1.0 + nrm(ks[10], (N_EVEN, B_WIDTH), 0.1),
        'w_out_even': nrm(ks[11], (N_EVEN, EVEN_MIX, D_MODEL), EVEN_MIX ** -0.5),
        'w_in_odd': nrm(ks[12], (N_ODD, D_MODEL, ODD_IN), D_MODEL ** -0.5),
        'b_forget': jax.random.uniform(ks[13], (N_ODD, C_HEADS), f32, 1.0, 5.0),
        'w_out_odd': nrm(ks[14], (N_ODD, C_WIDTH, D_MODEL), C_WIDTH ** -0.5),
        'w_up': nrm(ks[15], (DEPTH, D_MODEL, 2 * D_FF), D_MODEL ** -0.5),
        'conv_w': nrm(ks[16], (DEPTH, CONV_WIDTH, 2 * D_FF), CONV_WIDTH ** -0.5),
        'conv_b': nrm(ks[17], (DEPTH, 2 * D_FF), 0.02),
        'w_down': nrm(ks[18], (DEPTH, D_FF, D_MODEL), D_FF ** -0.5),
    }


def reference(x, norm_mix_g, norm_ffn_g, final_norm_g, w_in_even, ln_v_g, ln_v_b,
              w_spatial, b_spatial, w_pool, pool_scale, w_out_even, w_in_odd,
              b_forget, w_out_odd, w_up, conv_w, conv_b, w_down):
    bsz, s, _ = x.shape
    for i in range(DEPTH):
        h = rms_norm(x, norm_mix_g[i])
        if i % 2 == 0:
            e = i // 2
            p = h @ w_in_even[e]
            z = jax.nn.gelu(p[..., :2 * A_WIDTH], approximate=False)
            y_a = spatial_gating(z, ln_v_g[e], ln_v_b[e], w_spatial[e], b_spatial[e])
            y_b = multiscale_pool(p[..., 2 * A_WIDTH:], w_pool[e], pool_scale[e])
            mix = jnp.concatenate([y_a, y_b], axis=-1) @ w_out_even[e]
        else:
            o = i // 2
            p = h @ w_in_odd[o]
            q = p[..., :C_WIDTH].reshape(bsz, s, C_HEADS, C_HEAD_DIM)
            k = p[..., C_WIDTH:2 * C_WIDTH].reshape(bsz, s, C_HEADS, C_HEAD_DIM)
            v = p[..., 2 * C_WIDTH:3 * C_WIDTH].reshape(bsz, s, C_HEADS, C_HEAD_DIM)
            f_logit = (p[..., 3 * C_WIDTH:] + b_forget[o]).astype(jnp.float32)
            log_f = jax.nn.log_sigmoid(f_logit)
            att = forgetting_attention(q, k, v, log_f).reshape(bsz, s, C_WIDTH)
            mix = att @ w_out_odd[o]
        x = x + mix
        x = x + conv_ffn(rms_norm(x, norm_ffn_g[i]), w_up[i], conv_w[i], conv_b[i], w_down[i])
    return rms_norm(x, final_norm_g)
```

```cpp
#include <hip/hip_runtime.h>
#include <hip/hip_bf16.h>
#include <hip/hip_cooperative_groups.h>
#include <cstdio>
#include <cstdint>
namespace cg = cooperative_groups;

#define LAS __attribute__((address_space(3)))
typedef unsigned short bf16_t;
typedef short bf16x8 __attribute__((ext_vector_type(8)));
typedef short s16x4 __attribute__((ext_vector_type(4)));
typedef float f32x4 __attribute__((ext_vector_type(4)));
typedef float f32x2 __attribute__((ext_vector_type(2)));
typedef float f32x16 __attribute__((ext_vector_type(16)));
typedef unsigned u32x4 __attribute__((ext_vector_type(4)));
typedef unsigned u32x2 __attribute__((ext_vector_type(2)));

constexpr int DM = 2048, NB = 16, SEQ = 2048, MTOK = NB * SEQ;
constexpr int DFF = 5632, NUP = 2 * DFF;
constexpr int EVEN_IN = 3072, ODD_IN = 6160, ODD_PAD = 6400, QKV_LD = 6144;
constexpr int NHEAD = 16, HD = 128;
constexpr float EPS = 1e-6f;

__device__ __forceinline__ unsigned cvt_pk_bf16(float lo, float hi) { unsigned r; asm volatile("v_cvt_pk_bf16_f32 %0, %1, %2" : "=v"(r) : "v"(lo), "v"(hi)); return r; }
__device__ __forceinline__ float bf2f(unsigned short h) { return __uint_as_float(((unsigned)h) << 16); }
__device__ __forceinline__ float bflo(unsigned w) { return __uint_as_float(w << 16); }
__device__ __forceinline__ float bfhi(unsigned w) { return __uint_as_float(w & 0xffff0000u); }

__device__ __forceinline__ int lane_id() { int l; asm volatile("v_mbcnt_lo_u32_b32 %0, -1, 0\n\tv_mbcnt_hi_u32_b32 %0, -1, %0" : "=v"(l)); return l; }
__device__ __forceinline__ float rows_sum(float v) {
    { auto r = __builtin_amdgcn_permlane16_swap(__float_as_uint(v), __float_as_uint(v), false, false); v = __uint_as_float(r[0]) + __uint_as_float(r[1]); }
    { auto r = __builtin_amdgcn_permlane32_swap(__float_as_uint(v), __float_as_uint(v), false, false); v = __uint_as_float(r[0]) + __uint_as_float(r[1]); }
    return v;
}
namespace pg8 {
constexpr int BM = 256, BK = 64, HALF = 128, HTB = HALF * BK * 2, STAGE_BYTES = 8 * HTB, NXCD = 8, WGM = 8;
__host__ __device__ __forceinline__ int lds_byte(int r, int c) { const int st = (r >> 4) * 2 + (c >> 5), rr = r & 15, cc = c & 31, ob = rr * 64 + cc * 2; return st * 1024 + (ob ^ (((ob >> 9) & 1) << 5)); }
__host__ __device__ __forceinline__ void stage_rc(int b, int& R, int& C) { const int st = b / 1024, sb = b % 1024, swz = sb ^ (((sb >> 9) & 1) << 5); R = (st >> 1) * 16 + swz / 64; C = (st & 1) * 32 + (swz % 64) / 2; }
__host__ __device__ __forceinline__ int perm32(int rho) { const int n = rho >> 4, i = rho & 15; return 8 * (i >> 2) + 4 * n + (i & 3); }

struct Unit { int pm, pn; };
struct Gemm { const bf16_t* A; const bf16_t* Bt; int lda, ldb, K; int a_pn_off; };

struct StaticOrder {
    int nM, nN, nwg, G, c, wgm;
    __host__ __device__ void init(int M, int N, int G_, int c_, int wgm_ = WGM) { nM = M / BM; nN = N / BM; nwg = nM * nN; G = G_; c = c_; wgm = wgm_; }
    __host__ __device__ bool next(int i, Unit& u) const {
        const long L = (long)i * G + c; if (L >= nwg) return false;
        int wgid = (int)L; { const int q = nwg / NXCD, r = nwg % NXCD, xcd = wgid % NXCD, off = wgid / NXCD; wgid = (xcd < r ? xcd * (q + 1) : r * (q + 1) + (xcd - r) * q) + off; }
        const int nig = wgm * nN, gid = wgid / nig, fm = gid * wgm, gsz = (nM - fm) < wgm ? (nM - fm) : wgm;
        u.pm = fm + ((wgid % nig) % gsz); u.pn = (wgid % nig) / gsz; return true;
    }
};

__device__ __forceinline__ f32x2 gelu_pk(f32x2 v) {
    const f32x2 av = __builtin_elementwise_abs(v), d = av * 0.2316418882f + 1.0f;
    f32x2 t; t.x = __builtin_amdgcn_rcpf(d.x); t.y = __builtin_amdgcn_rcpf(d.y);
    f32x2 q = t * 0.5307027145f + (-0.7265760135f); q = q * t + 0.7107068705f; q = q * t + (-0.142248368f); q = q * t + 0.127414796f; q = q * t;
    const f32x2 s = (v * v) * (-0.72134752044f);
    f32x2 e; e.x = __builtin_amdgcn_exp2f(s.x); e.y = __builtin_amdgcn_exp2f(s.y);
    const f32x2 m = v * (q * e), r = v - m;
    f32x2 o; o.x = v.x < 0.f ? m.x : r.x; o.y = v.y < 0.f ? m.y : r.y; return o;
}

__device__ __forceinline__ void load_rstd(float (&rs)[2][4], const float* ss, int rowbase) {
#pragma unroll
    for (int ai = 0; ai < 2; ++ai)
#pragma unroll
        for (int m = 0; m < 4; ++m) rs[ai][m] = __builtin_amdgcn_rsqf(ss[rowbase + ai * HALF + m * 16] * (1.0f / DM) + EPS);
}

template <bool HAS_LF> struct EpiZ {
    static constexpr bool PERM = true, PERMA = false, AFTER_DRAIN = false;
    bf16_t* O; int ldc; const float* ss; int gelu_tiles; int lf_tile; const float* bfg; float* LF;
    __device__ __forceinline__ void operator()(const f32x4 (&acc)[2][2][4][2], const Unit& u, int wr, int wc, int fr, int fq) const {
        const int row0 = u.pm * BM + wr * 64 + fr;
        float rs[2][4]; load_rstd(rs, ss, row0);
        if (HAS_LF && u.pn == lf_tile) {
            if (wc == 0 && fq < 2) {
#pragma unroll
                for (int ai = 0; ai < 2; ++ai)
#pragma unroll
                    for (int m = 0; m < 4; ++m) { const int row = row0 + ai * HALF + m * 16;
#pragma unroll
                        for (int n = 0; n < 2; ++n) { const f32x4 v = acc[ai][0][m][n] * rs[ai][m]; const int col = 8 * fq + 4 * n; f32x4 o;
#pragma unroll
                            for (int e = 0; e < 4; ++e) o[e] = v[e];
                            *(f32x4*)(LF + (size_t)row * 16 + col) = o; } }
            }
            return;
        }
        const int col0 = u.pn * BM + wc * 32 + 8 * fq; const bool act = u.pn < gelu_tiles;
#pragma unroll
        for (int ai = 0; ai < 2; ++ai)
#pragma unroll
            for (int m = 0; m < 4; ++m) { bf16_t* rowp = O + (size_t)(row0 + ai * HALF + m * 16) * ldc + col0; const float r = rs[ai][m];
#pragma unroll
                for (int bj = 0; bj < 2; ++bj) { f32x4 v0 = acc[ai][bj][m][0] * r, v1 = acc[ai][bj][m][1] * r;
                    if (act) { f32x2 a = gelu_pk((f32x2){v0[0], v0[1]}), b = gelu_pk((f32x2){v0[2], v0[3]}), c = gelu_pk((f32x2){v1[0], v1[1]}), d = gelu_pk((f32x2){v1[2], v1[3]});
                        v0 = (f32x4){a.x, a.y, b.x, b.y}; v1 = (f32x4){c.x, c.y, d.x, d.y}; }
                    u32x4 w; w.x = cvt_pk_bf16(v0[0], v0[1]); w.y = cvt_pk_bf16(v0[2], v0[3]); w.z = cvt_pk_bf16(v1[0], v1[1]); w.w = cvt_pk_bf16(v1[2], v1[3]);
                    *(u32x4*)(rowp + bj * HALF) = w; } }
    }
};
struct EpiPool {
    static constexpr bool PERM = true, PERMA = false, AFTER_DRAIN = false;
    bf16_t* O; int ldc; int col_off; const float* scale;
    __device__ __forceinline__ void operator()(const f32x4 (&acc)[2][2][4][2], const Unit& u, int wr, int wc, int fr, int fq) const {
        const int row0 = u.pm * BM + wr * 64 + fr; const int col0 = u.pn * BM + wc * 32 + 8 * fq;
        f32x4 sv[2][2];
#pragma unroll
        for (int bj = 0; bj < 2; ++bj)
#pragma unroll
            for (int n = 0; n < 2; ++n) sv[bj][n] = scale ? *(const f32x4*)(scale + col0 + bj * HALF + 4 * n) : (f32x4){1.f, 1.f, 1.f, 1.f};
#pragma unroll
        for (int ai = 0; ai < 2; ++ai)
#pragma unroll
            for (int m = 0; m < 4; ++m) { bf16_t* rowp = O + (size_t)(row0 + ai * HALF + m * 16) * ldc + col_off + col0;
#pragma unroll
                for (int bj = 0; bj < 2; ++bj) { const f32x4 v0 = acc[ai][bj][m][0] * sv[bj][0], v1 = acc[ai][bj][m][1] * sv[bj][1];
                    u32x4 w; w.x = cvt_pk_bf16(v0[0], v0[1]); w.y = cvt_pk_bf16(v0[2], v0[3]); w.z = cvt_pk_bf16(v1[0], v1[1]); w.w = cvt_pk_bf16(v1[2], v1[3]);
                    *(u32x4*)(rowp + bj * HALF) = w; } }
    }
};
template <bool B16> struct EpiRes {
    static constexpr bool PERM = true, PERMA = false, AFTER_DRAIN = false;
    const float* base; const bf16_t* base16; float* out; bf16_t* xb; float* ss_out;
    __device__ __forceinline__ void operator()(const f32x4 (&acc)[2][2][4][2], const Unit& u, int wr, int wc, int fr, int fq) const {
        const int row0 = u.pm * BM + wr * 64 + fr; const int col0 = u.pn * BM + wc * 32 + 8 * fq;
#pragma unroll
        for (int ai = 0; ai < 2; ++ai) {
            f32x4 pre[4][2][2]; u32x4 p16[4][2];
#pragma unroll
            for (int m = 0; m < 4; ++m) { const size_t off = (size_t)(row0 + ai * HALF + m * 16) * DM + col0;
#pragma unroll
                for (int bj = 0; bj < 2; ++bj) {
                    if constexpr (B16) p16[m][bj] = *(const u32x4*)(base16 + off + bj * HALF);
                    else { pre[m][bj][0] = *(const f32x4*)(base + off + bj * HALF); pre[m][bj][1] = *(const f32x4*)(base + off + bj * HALF + 4); } } }
            asm volatile("" ::: "memory");
#pragma unroll
            for (int m = 0; m < 4; ++m) { const int row = row0 + ai * HALF + m * 16; const size_t off = (size_t)row * DM + col0; float s = 0.f;
#pragma unroll
                for (int bj = 0; bj < 2; ++bj) {
                    f32x4 b0, b1;
                    if constexpr (B16) { const u32x4 p = p16[m][bj]; b0 = (f32x4){bflo(p.x), bfhi(p.x), bflo(p.y), bfhi(p.y)}; b1 = (f32x4){bflo(p.z), bfhi(p.z), bflo(p.w), bfhi(p.w)}; }
                    else { b0 = pre[m][bj][0]; b1 = pre[m][bj][1]; }
                    const f32x4 o0 = b0 + acc[ai][bj][m][0], o1 = b1 + acc[ai][bj][m][1];
                    if (out) { *(f32x4*)(out + off + bj * HALF) = o0; *(f32x4*)(out + off + bj * HALF + 4) = o1; }
                    s += ((o0[0] * o0[0] + o0[1] * o0[1]) + (o0[2] * o0[2] + o0[3] * o0[3])) + ((o1[0] * o1[0] + o1[1] * o1[1]) + (o1[2] * o1[2] + o1[3] * o1[3]));
                    { u32x4 w; w.x = cvt_pk_bf16(o0[0], o0[1]); w.y = cvt_pk_bf16(o0[2], o0[3]); w.z = cvt_pk_bf16(o1[0], o1[1]); w.w = cvt_pk_bf16(o1[2], o1[3]); *(u32x4*)(xb + off + bj * HALF) = w; } }
                s = rows_sum(s);
                if (fq == 0) __hip_atomic_fetch_add(ss_out + row, s, __ATOMIC_RELAXED, __HIP_MEMORY_SCOPE_AGENT);
            }
            asm volatile("" ::: "memory");
        }
    }
};
template <int CTRL> __device__ __forceinline__ float dppz(float src) {
    return __builtin_bit_cast(float, __builtin_amdgcn_update_dpp(0, __builtin_bit_cast(int, src), CTRL, 0xf, 0xf, true));
}
__device__ __forceinline__ f32x2 silu_mul_pk(f32x2 g, f32x2 v) {
    const f32x2 t = g * (-1.4426950408889634f); f32x2 e; e.x = __builtin_amdgcn_exp2f(t.x); e.y = __builtin_amdgcn_exp2f(t.y);
    const f32x2 d = e + 1.0f; f32x2 r; r.x = __builtin_amdgcn_rcpf(d.x); r.y = __builtin_amdgcn_rcpf(d.y);
    return (g * r) * v;
}
__device__ __forceinline__ float silu_f(float x) { return x * __builtin_amdgcn_rcpf(1.0f + __builtin_amdgcn_exp2f(-1.4426950408889634f * x)); }
struct EpiUpConv {
    static constexpr bool PERM = true, PERMA = true, AFTER_DRAIN = false;
    bf16_t* ACT; float* RAW; const float* ss; const float* cw; const float* cb;
    __device__ __forceinline__ void operator()(const f32x4 (&acc)[2][2][4][2], const Unit& u, int wr, int wc, int fr, int fq) const {
        const int rbase = u.pm * BM + wr * 64 + 4 * fr;
        float rs[2][4];
#pragma unroll
        for (int ai = 0; ai < 2; ++ai) { const f32x4 sv = *(const f32x4*)(ss + rbase + ai * HALF);
#pragma unroll
            for (int m = 0; m < 4; ++m) rs[ai][m] = __builtin_amdgcn_rsqf(sv[m] * (1.0f / DM) + EPS); }
        u32x2 keep[2][4];
#pragma unroll
        for (int n = 0; n < 2; ++n) {
            const int ci = wc * 32 + 8 * fq + 4 * n, cgc = u.pn * HALF + ci;
            const f32x4 g0 = *(const f32x4*)(cw + cgc), g1 = *(const f32x4*)(cw + NUP + cgc), g2 = *(const f32x4*)(cw + 2 * NUP + cgc), gb = *(const f32x4*)(cb + cgc);
            const f32x4 v0 = *(const f32x4*)(cw + DFF + cgc), v1 = *(const f32x4*)(cw + NUP + DFF + cgc), v2 = *(const f32x4*)(cw + 2 * NUP + DFF + cgc), vb = *(const f32x4*)(cb + DFF + cgc);
#pragma unroll
            for (int ai = 0; ai < 2; ++ai) {
                float* rawp = RAW + ((size_t)(u.pm * 4 + ai * 2 + wr) * 4) * NUP + u.pn * BM + ci;
                f32x4 G[4], V[4];
#pragma unroll
                for (int m = 0; m < 4; ++m) { G[m] = acc[ai][0][m][n] * rs[ai][m]; V[m] = acc[ai][1][m][n] * rs[ai][m]; }
                f32x4 G3s, G2s, V3s, V2s;
#pragma unroll
                for (int e = 0; e < 4; ++e) { G3s[e] = dppz<0x111>(G[3][e]); G2s[e] = dppz<0x111>(G[2][e]); V3s[e] = dppz<0x111>(V[3][e]); V2s[e] = dppz<0x111>(V[2][e]); }
                f32x4 cg[4], cv[4];
                cg[0] = gb + g0 * G2s + g1 * G3s + g2 * G[0]; cv[0] = vb + v0 * V2s + v1 * V3s + v2 * V[0];
                cg[1] = gb + g0 * G3s + g1 * G[0] + g2 * G[1]; cv[1] = vb + v0 * V3s + v1 * V[0] + v2 * V[1];
                cg[2] = gb + g0 * G[0] + g1 * G[1] + g2 * G[2]; cv[2] = vb + v0 * V[0] + v1 * V[1] + v2 * V[2];
                cg[3] = gb + g0 * G[1] + g1 * G[2] + g2 * G[3]; cv[3] = vb + v0 * V[1] + v1 * V[2] + v2 * V[3];
#pragma unroll
                for (int m = 0; m < 4; ++m) {
                    const f32x2 a01 = silu_mul_pk((f32x2){cg[m][0], cg[m][1]}, (f32x2){cv[m][0], cv[m][1]}), a23 = silu_mul_pk((f32x2){cg[m][2], cg[m][3]}, (f32x2){cv[m][2], cv[m][3]});
                    u32x2 w; w.x = cvt_pk_bf16(a01.x, a01.y); w.y = cvt_pk_bf16(a23.x, a23.y);
                    if (n == 0) keep[ai][m] = w;
                    else if (m >= 2 || fr != 0) { u32x4 o; o.x = keep[ai][m].x; o.y = keep[ai][m].y; o.z = w.x; o.w = w.y;
                        *(u32x4*)(ACT + (size_t)(rbase + ai * HALF + m) * DFF + u.pn * HALF + wc * 32 + 8 * fq) = o; }
                }
                if (fr == 0) { *(f32x4*)(rawp) = G[0]; *(f32x4*)(rawp + HALF) = V[0]; *(f32x4*)(rawp + NUP) = G[1]; *(f32x4*)(rawp + NUP + HALF) = V[1]; }
                if (fr == 15) { *(f32x4*)(rawp + 2 * (size_t)NUP) = G[2]; *(f32x4*)(rawp + 2 * (size_t)NUP + HALF) = V[2]; *(f32x4*)(rawp + 3 * (size_t)NUP) = G[3]; *(f32x4*)(rawp + 3 * (size_t)NUP + HALF) = V[3]; }
            }
        }
    }
};
template <class Epi, class Sched, bool ALIGN_EPI = false, bool SP2 = false>
__device__ __forceinline__ void gemm_phase(LAS unsigned char* lds, const Gemm g, const Sched& S, const Epi& E, int wid) {
    asm volatile("" : "+s"(wid));
    int lane = lane_id(); asm volatile("" : "+v"(lane));
    const int tid = wid * 64 + lane, wr = wid >> 2, wc = wid & 3, fr = lane & 15, fq = lane >> 4;
    const int K = g.K, nt = K / BK;
    unsigned voffA[2], voffB[2];
#pragma unroll
    for (int i = 0; i < 2; ++i) { int R, C; stage_rc(tid * 16 + i * 8192, R, C); const int Rb = Epi::PERM ? ((R & ~31) + perm32(R & 31)) : R;
        const int Ra = Epi::PERMA ? ((R & ~63) + 4 * (R & 15) + ((R >> 4) & 3)) : R;
        voffA[i] = (unsigned)(Ra * g.lda + C) * 2u; voffB[i] = (unsigned)(Rb * g.ldb + C) * 2u; }
    const size_t kstep = (size_t)(BK * 2);
    const size_t hstepA = (size_t)HALF * g.lda * 2, hstepB = (size_t)HALF * g.ldb * 2;
    const size_t tstepA = 2 * hstepA, tstepB = 2 * hstepB;
    const unsigned ldsw = (unsigned)wid * 1024u;
    const int aoff = lds_byte(wr * 64 + fr, fq * 8), boff = lds_byte(wc * 32 + fr, fq * 8);
#define PG8_SA(b, h) (((b) * 2 + (h)) * HTB)
#define PG8_SB(b, h) ((4 + (b) * 2 + (h)) * HTB)
#define PG8_STAGE(bufoff, gbase, voff) do { _Pragma("unroll") for (int _i = 0; _i < 2; ++_i) \
        __builtin_amdgcn_global_load_lds((const unsigned*)((const char*)(gbase) + (voff)[_i]), (LAS unsigned*)(lds + (bufoff) + ldsw + _i * 8192), 16, 0, 0); } while (0)
#define PG8_LDA(dst, b, h) do { _Pragma("unroll") for (int m = 0; m < 4; ++m) _Pragma("unroll") for (int k = 0; k < 2; ++k) dst[m][k] = *(const LAS bf16x8*)(lds + PG8_SA(b, h) + aoff + m * 2048 + k * 1024); } while (0)
#define PG8_LDB(dst, b, h) do { _Pragma("unroll") for (int n = 0; n < 2; ++n) _Pragma("unroll") for (int k = 0; k < 2; ++k) dst[n][k] = *(const LAS bf16x8*)(lds + PG8_SB(b, h) + boff + n * 2048 + k * 1024); } while (0)
#define PG8_MMA(ai, bj, At, Bt) do { __builtin_amdgcn_s_setprio(1); _Pragma("unroll") for (int m = 0; m < 4; ++m) _Pragma("unroll") for (int n = 0; n < 2; ++n) _Pragma("unroll") for (int k = 0; k < 2; ++k) \
        acc[ai][bj][m][n] = __builtin_amdgcn_mfma_f32_16x16x32_bf16(Bt[n][k], At[m][k], acc[ai][bj][m][n], 0, 0, 0); __builtin_amdgcn_s_setprio(0); } while (0)
#define PG8_WAIT_V(n) asm volatile("s_waitcnt vmcnt(" #n ")" ::: "memory")
#define PG8_WAIT_L(n) asm volatile("s_waitcnt lgkmcnt(" #n ")" ::: "memory")
#define PG8_BAR __builtin_amdgcn_s_barrier()
#define PG8_SCHED __builtin_amdgcn_sched_barrier(0)
    Unit cur, nxt; int ui = 0;
    if (!S.next(0, cur)) return;
    f32x4 acc[2][2][4][2];
#pragma unroll
    for (int a = 0; a < 2; ++a)
#pragma unroll
        for (int b = 0; b < 2; ++b)
#pragma unroll
            for (int m = 0; m < 4; ++m)
#pragma unroll
                for (int n = 0; n < 2; ++n) acc[a][b][m][n] = (f32x4){0.f, 0.f, 0.f, 0.f};
    bf16x8 At[4][2], B0[2][2], B1[2][2];
    const char* cA = (const char*)g.A + (size_t)cur.pm * tstepA + (size_t)cur.pn * g.a_pn_off; const char* cB = (const char*)g.Bt + (size_t)cur.pn * tstepB;
    if constexpr (SP2) {
        PG8_STAGE(PG8_SB(0, 0), cB, voffB); PG8_STAGE(PG8_SB(0, 1), cB + hstepB, voffB); PG8_STAGE(PG8_SA(0, 0), cA, voffA); PG8_STAGE(PG8_SA(0, 1), cA + hstepA, voffA);
        if (wr == 1) PG8_BAR;
        PG8_WAIT_V(2); PG8_BAR;
        PG8_STAGE(PG8_SB(1, 0), cB + kstep, voffB); PG8_STAGE(PG8_SA(1, 0), cA + kstep, voffA); PG8_STAGE(PG8_SB(1, 1), cB + hstepB + kstep, voffB);
        PG8_WAIT_V(6); PG8_BAR;
    } else {
        PG8_STAGE(PG8_SB(0, 0), cB, voffB); PG8_STAGE(PG8_SA(0, 0), cA, voffA); PG8_STAGE(PG8_SB(0, 1), cB + hstepB, voffB); PG8_STAGE(PG8_SA(0, 1), cA + hstepA, voffA);
        if (wr == 1) PG8_BAR;
        PG8_WAIT_V(4); PG8_BAR;
        PG8_STAGE(PG8_SB(1, 0), cB + kstep, voffB); PG8_STAGE(PG8_SA(1, 0), cA + kstep, voffA); PG8_STAGE(PG8_SB(1, 1), cB + hstepB + kstep, voffB);
        PG8_WAIT_V(6); PG8_BAR;
    }
    for (;;) {
        const bool has_next = S.next(ui + 1, nxt);
        const char* nA = has_next ? (const char*)g.A + (size_t)nxt.pm * tstepA + (size_t)nxt.pn * g.a_pn_off : cA; const char* nB = has_next ? (const char*)g.Bt + (size_t)nxt.pn * tstepB : cB;
#pragma nounroll
        for (int t = 0; t < nt; t += 2) {
            const bool last = (t == nt - 2);
            const char* a1 = cA + (size_t)(t + 1) * kstep;
            const char* a2 = last ? nA : cA + (size_t)(t + 2) * kstep; const char* b2 = last ? nB : cB + (size_t)(t + 2) * kstep;
            const char* a3 = a2 + kstep; const char* b3 = b2 + kstep;
            if constexpr (SP2) {
            PG8_LDB(B0, 0, 0); PG8_LDB(B1, 0, 1); PG8_SCHED; PG8_LDA(At, 0, 0); PG8_STAGE(PG8_SA(1, 1), a1 + hstepA, voffA);
            PG8_WAIT_V(8); PG8_WAIT_L(0); PG8_BAR; PG8_MMA(0, 0, At, B0); PG8_MMA(0, 1, At, B1); PG8_BAR; PG8_SCHED;
            PG8_LDA(At, 0, 1); PG8_STAGE(PG8_SB(0, 0), b2, voffB); PG8_STAGE(PG8_SB(0, 1), b2 + hstepB, voffB); PG8_STAGE(PG8_SA(0, 0), a2, voffA);
            PG8_WAIT_V(8); PG8_WAIT_L(0); PG8_BAR; PG8_MMA(1, 0, At, B0); PG8_MMA(1, 1, At, B1); PG8_BAR; PG8_SCHED;
            PG8_LDB(B0, 1, 0); PG8_LDB(B1, 1, 1); PG8_SCHED; PG8_LDA(At, 1, 0); PG8_STAGE(PG8_SA(0, 1), a2 + hstepA, voffA);
            PG8_WAIT_V(8); PG8_WAIT_L(0); PG8_BAR; PG8_MMA(0, 0, At, B0); PG8_MMA(0, 1, At, B1); PG8_BAR; PG8_SCHED;
            PG8_LDA(At, 1, 1); PG8_STAGE(PG8_SB(1, 0), b3, voffB); PG8_STAGE(PG8_SB(1, 1), b3 + hstepB, voffB); PG8_STAGE(PG8_SA(1, 0), a3, voffA);
            PG8_WAIT_V(8); PG8_WAIT_L(0); PG8_BAR; PG8_MMA(1, 0, At, B0); PG8_MMA(1, 1, At, B1); PG8_BAR; PG8_SCHED;
            } else {
            PG8_LDB(B0, 0, 0); PG8_SCHED; PG8_LDA(At, 0, 0); PG8_STAGE(PG8_SA(1, 1), a1 + hstepA, voffA);
            PG8_WAIT_L(8); PG8_BAR; PG8_WAIT_L(0); PG8_MMA(0, 0, At, B0); PG8_BAR; PG8_SCHED;
            PG8_LDB(B1, 0, 1); PG8_STAGE(PG8_SB(0, 0), b2, voffB);
            PG8_BAR; PG8_WAIT_L(0); PG8_MMA(0, 1, At, B1); PG8_BAR;
            PG8_LDA(At, 0, 1); PG8_STAGE(PG8_SA(0, 0), a2, voffA);
            PG8_BAR; PG8_WAIT_L(0); PG8_MMA(1, 0, At, B0); PG8_BAR; PG8_SCHED;
            PG8_STAGE(PG8_SB(0, 1), b2 + hstepB, voffB);
            PG8_WAIT_V(6); PG8_BAR; PG8_MMA(1, 1, At, B1); PG8_BAR;
            PG8_LDB(B0, 1, 0); PG8_SCHED; PG8_LDA(At, 1, 0); PG8_STAGE(PG8_SA(0, 1), a2 + hstepA, voffA);
            PG8_WAIT_L(8); PG8_BAR; PG8_WAIT_L(0); PG8_MMA(0, 0, At, B0); PG8_BAR; PG8_SCHED;
            PG8_LDB(B1, 1, 1); PG8_STAGE(PG8_SB(1, 0), b3, voffB);
            PG8_BAR; PG8_WAIT_L(0); PG8_MMA(0, 1, At, B1); PG8_BAR;
            PG8_LDA(At, 1, 1); PG8_STAGE(PG8_SA(1, 0), a3, voffA);
            PG8_BAR; PG8_WAIT_L(0); PG8_MMA(1, 0, At, B0); PG8_BAR; PG8_SCHED;
            PG8_STAGE(PG8_SB(1, 1), b3 + hstepB, voffB);
            PG8_WAIT_V(6); PG8_BAR; PG8_MMA(1, 1, At, B1); PG8_BAR;
            }
        }
        if constexpr (ALIGN_EPI) { if (wr == 0) PG8_BAR; }
        E(acc, cur, wr, wc, fr, fq);
        if (!has_next) break;
#pragma unroll
        for (int a = 0; a < 2; ++a)
#pragma unroll
            for (int b = 0; b < 2; ++b)
#pragma unroll
                for (int m = 0; m < 4; ++m)
#pragma unroll
                    for (int n = 0; n < 2; ++n) acc[a][b][m][n] = (f32x4){0.f, 0.f, 0.f, 0.f};
        cur = nxt; cA = nA; cB = nB; ++ui;
        if constexpr (ALIGN_EPI) { if (wr == 1) PG8_BAR; }
    }
    PG8_WAIT_V(0);
    if constexpr (!ALIGN_EPI) { if (wr == 0) PG8_BAR; }
    PG8_BAR;
#undef PG8_SA
#undef PG8_SB
#undef PG8_STAGE
#undef PG8_LDA
#undef PG8_LDB
#undef PG8_MMA
#undef PG8_WAIT_V
#undef PG8_WAIT_L
#undef PG8_BAR
#undef PG8_SCHED
}
}

namespace fox {
using bf16 = __hip_bfloat16;
constexpr int D = 128;
constexpr float SCALE = 0.08838834764831845f;
constexpr float THR = 8.f;
constexpr int NW = 8, QBLK = 32, KVBLK = 64, QB = NW * QBLK;
constexpr int SHM_V = KVBLK * D * 2, SHM_K = KVBLK * D * 2;
constexpr int OFF_WS = 2 * SHM_V + 2 * SHM_K, OFF_BIAS = OFF_WS + NW * 64 * 4;
constexpr int LDS_BYTES = OFF_BIAS + 2048 * 4;
constexpr int LDQ = QKV_LD, LDO = DM;

#define KSWZ(row, colB) ((row) * 256 + ((colB) ^ (((row) & 7) << 4)))
#define SBAR() __builtin_amdgcn_sched_barrier(0)
__device__ __forceinline__ int v_st(int k, int c) { const int kk = (k & ~0xC) | ((k & 4) << 1) | ((k & 8) >> 1); return ((kk >> 3) * 4 + (c >> 5)) * 512 + ((kk & 7) * 32 + (c & 31)) * 2; }
__device__ __forceinline__ int v_rd_base(int lane) { return ((lane & 3) << 3) | (((lane >> 2) & 3) << 6) | (((lane >> 4) & 1) << 5) | (((lane >> 5) & 1) << 8); }
constexpr int v_rd_off(int d0, int ks, int half) { return d0 * 512 + ks * 4096 + half * 2048; }
__device__ __forceinline__ int crow(int r, int hi) { return (r & 3) + 8 * (r >> 2) + 4 * hi; }
__device__ __forceinline__ unsigned cvtpk(float lo, float hi) { unsigned r; asm volatile("v_cvt_pk_bf16_f32 %0, %1, %2" : "=v"(r) : "v"(lo), "v"(hi)); return r; }
__device__ __forceinline__ bf16x8 load8(const bf16* p) { return *reinterpret_cast<const bf16x8*>(p); }
__device__ __forceinline__ void mask_tile(f32x16& p0, f32x16& p1, int dq, unsigned W) {
    const float NEG = -__builtin_inff();
#pragma unroll
    for (int r = 0; r < 16; ++r) {
        const int c = (r & 3) + 8 * (r >> 2);
        if ((unsigned)(dq - c) >= W) p0[r] = NEG;
        if ((unsigned)(dq - c - 32) >= W) p1[r] = NEG;
    }
}
__device__ __forceinline__ void partialSM(f32x16& p0, f32x16& p1, float& m_reg, float& mn, float& alpha) {
    float pmax = p0[0]; for (int r = 1; r < 16; ++r) pmax = fmaxf(pmax, p0[r]); for (int r = 0; r < 16; ++r) pmax = fmaxf(pmax, p1[r]);
    { auto rr = __builtin_amdgcn_permlane32_swap(__float_as_uint(pmax), __float_as_uint(pmax), false, false);
      pmax = fmaxf(__uint_as_float(rr[0]), __uint_as_float(rr[1])); }
    constexpr float C2 = 1.4426950408889634f * SCALE;
    if (__builtin_expect(__all((pmax - m_reg) * SCALE <= THR), 1)) { mn = m_reg; alpha = 1.f; }
    else { mn = fmaxf(m_reg, pmax); alpha = __builtin_amdgcn_exp2f((m_reg - mn) * C2); m_reg = mn; }
    const float mnL = -mn * C2;
    for (int r = 0; r < 16; ++r) p0[r] = fmaf(p0[r], C2, mnL); for (int r = 0; r < 16; ++r) p1[r] = fmaf(p1[r], C2, mnL);
    for (int r = 0; r < 16; ++r) p0[r] = __builtin_amdgcn_exp2f(p0[r]);
}
__device__ __forceinline__ void finishSM(f32x16& p0, f32x16& p1, float alpha, float& l_reg, bf16x8& pa0, bf16x8& pa1, bf16x8& pa2, bf16x8& pa3) {
    for (int r = 0; r < 16; ++r) p1[r] = __builtin_amdgcn_exp2f(p1[r]);
    float ps = 0; for (int r = 0; r < 16; ++r) ps += p0[r]; for (int r = 0; r < 16; ++r) ps += p1[r];
    { auto rr = __builtin_amdgcn_permlane32_swap(__float_as_uint(ps), __float_as_uint(ps), false, false);
      ps = __uint_as_float(rr[0]) + __uint_as_float(rr[1]); }
    l_reg = l_reg * alpha + ps;
#define PK4(P, B_, OUT) do { unsigned a0 = cvtpk(P[B_+0], P[B_+1]), a1 = cvtpk(P[B_+2], P[B_+3]);                          \
        unsigned b0 = cvtpk(P[B_+4], P[B_+5]), b1 = cvtpk(P[B_+6], P[B_+7]);                                             \
        auto r0 = __builtin_amdgcn_permlane32_swap(a0, b0, false, false); auto r1 = __builtin_amdgcn_permlane32_swap(a1, b1, false, false); \
        u32x4 w = {r0[0], r1[0], r0[1], r1[1]}; OUT = *reinterpret_cast<bf16x8*>(&w); } while (0)
    PK4(p0, 0, pa0); PK4(p0, 8, pa1); PK4(p1, 0, pa2); PK4(p1, 8, pa3);
#undef PK4
}
template <int KB>
__device__ __forceinline__ void qkt(f32x16& p0, f32x16& p1, const char* K_lds, const float* bias_t, int r32, int hi, const bf16x8* qr) {
    const float* bl = bias_t + 4 * hi;
#pragma unroll
    for (int j = 0; j < 4; ++j) { const f32x4 a = *(const f32x4*)(bl + 8 * j), b = *(const f32x4*)(bl + 32 + 8 * j);
#pragma unroll
        for (int e = 0; e < 4; ++e) { p0[4 * j + e] = a[e]; p1[4 * j + e] = b[e]; } }
    const char* kb[4];
#pragma unroll
    for (int dd = 0; dd < 4; ++dd) kb[dd] = K_lds + KB * SHM_K + KSWZ(r32, (dd * 16 + hi * 8) * 2);
#pragma unroll
    for (int d0 = 0; d0 < 8; ++d0) { const char* a = kb[d0 & 3] + (d0 >> 2) * 128;
        bf16x8 b0 = *reinterpret_cast<const bf16x8*>(a);
        bf16x8 b1 = *reinterpret_cast<const bf16x8*>(a + 32 * 256);
        p0 = __builtin_amdgcn_mfma_f32_32x32x16_bf16(b0, qr[d0], p0, 0, 0, 0);
        p1 = __builtin_amdgcn_mfma_f32_32x32x16_bf16(b1, qr[d0], p1, 0, 0, 0); }
}
template <int VB>
__device__ __forceinline__ void pv_tile(f32x16* o, int vb0, bf16x8 pa0, bf16x8 pa1, bf16x8 pa2, bf16x8 pa3) {
#define TRRD(dst, off) asm volatile("ds_read_b64_tr_b16 %0, %1 offset:%2" : "=&v"(dst) : "v"(vb0), "i"(off) : "memory")
#define PV_D0(d0) do { s16x4 l0, l1, l2, l3, h0, h1, h2, h3; constexpr int b_ = VB * SHM_V + v_rd_off(d0, 0, 0); \
        TRRD(l0, b_); TRRD(h0, b_ + 2048); TRRD(l1, b_ + 4096); TRRD(h1, b_ + 6144); TRRD(l2, b_ + 8192); TRRD(h2, b_ + 10240); TRRD(l3, b_ + 12288); TRRD(h3, b_ + 14336); \
        asm volatile("s_waitcnt lgkmcnt(0)" ::: "memory"); SBAR();   \
        o[d0] = __builtin_amdgcn_mfma_f32_32x32x16_bf16(pa0, (bf16x8){l0[0], l0[1], l0[2], l0[3], h0[0], h0[1], h0[2], h0[3]}, o[d0], 0, 0, 0);   \
        o[d0] = __builtin_amdgcn_mfma_f32_32x32x16_bf16(pa1, (bf16x8){l1[0], l1[1], l1[2], l1[3], h1[0], h1[1], h1[2], h1[3]}, o[d0], 0, 0, 0);   \
        o[d0] = __builtin_amdgcn_mfma_f32_32x32x16_bf16(pa2, (bf16x8){l2[0], l2[1], l2[2], l2[3], h2[0], h2[1], h2[2], h2[3]}, o[d0], 0, 0, 0);   \
        o[d0] = __builtin_amdgcn_mfma_f32_32x32x16_bf16(pa3, (bf16x8){l3[0], l3[1], l3[2], l3[3], h3[0], h3[1], h3[2], h3[3]}, o[d0], 0, 0, 0); } while (0)
    PV_D0(0); PV_D0(1); PV_D0(2); PV_D0(3);
#undef PV_D0
#undef TRRD
}
struct BlockRef { const bf16* Q; const bf16* K; const bf16* V; const float* Bias; bf16* O; int P0; };
struct Seam { bf16x8 qr[8]; bf16x8 st_v0, st_v1, st_k0, st_k1; };
#define GROW(p, k0, vo) ((const bf16*)((const char*)((p) + (size_t)(k0) * LDQ) + (vo)))
#define VMW() asm volatile("s_waitcnt vmcnt(0)" ::: "memory")
#define VMWN(n) asm volatile("s_waitcnt vmcnt(%0)" :: "i"(n) : "memory")
#define SLOAD_H(Kp, Vp, Bp, k0) do { S.st_v0 = load8(GROW(Vp, k0, voffk0)); S.st_v1 = load8(GROW(Vp, k0, voffk1));              \
                         S.st_k0 = load8(GROW(Kp, k0, voffk0)); S.st_k1 = load8(GROW(Kp, k0, voffk1)); } while (0)
#define SWRITE_HK(bf) do { *(bf16x8*)(K_lds + (bf) * SHM_K + kws) = S.st_k0; *(bf16x8*)(K_lds + (bf) * SHM_K + kws + 32 * 256) = S.st_k1; } while (0)
#define SWRITE_HV(bf) do { *(bf16x8*)(V_lds + (bf) * SHM_V + vst0) = S.st_v0; *(bf16x8*)(V_lds + (bf) * SHM_V + vst1) = S.st_v1; } while (0)
#define SWRITE_H(bf) do { SWRITE_HV(bf); SWRITE_HK(bf); } while (0)
__device__ __forceinline__ void fox_prime(const BlockRef& cur, char* lds, Seam& S, int wid) {
    asm volatile("" : "+s"(wid));
    int lane = lane_id(); asm volatile("" : "+v"(lane));
    const int tid = wid * 64 + lane, r32 = lane & 31, hi = lane >> 5;
    const int sr = tid >> 4, sc = (tid & 15) * 8, kws = KSWZ(sr, sc * 2); char* K_lds = lds + 2 * SHM_V;
    const unsigned voffk0 = (unsigned)(sr * LDQ + sc) * 2u, voffk1 = voffk0 + 32u * LDQ * 2u, voffq = (unsigned)(r32 * LDQ + hi * 8) * 2u;
    for (int d0 = 0; d0 < 8; ++d0) S.qr[d0] = load8((const bf16*)((const char*)(cur.Q + (size_t)(wid * QBLK) * LDQ) + voffq) + d0 * 16);
    SLOAD_H(cur.K, cur.V, cur.Bias, ((cur.P0 + QB - 1) / KVBLK) * KVBLK); VMW(); SWRITE_HK(0);
    __syncthreads();
}
__device__ __forceinline__ void fox_block(const BlockRef& cur, const BlockRef& nxt, char* lds, Seam& S, int wid) {
    asm volatile("" : "+s"(wid));
    int lane = lane_id(); asm volatile("" : "+v"(lane));
    const int tid = wid * 64 + lane, r32 = lane & 31, hi = lane >> 5;
    constexpr int W = 1 << 30;
    const int NT = (cur.P0 + QB - 1) / KVBLK + 1;
    const int qlo = cur.P0 + wid * QBLK, qm = qlo + r32 - 4 * hi;
    char* V_lds = lds; char* K_lds = lds + 2 * SHM_V; float* bias_lds = (float*)(lds + OFF_BIAS);
    float* ws = (float*)(lds + OFF_WS) + wid * 64; float* li_l = ws, * al_l = ws + 32;
    float m_reg = -1e30f, l_reg = 0; f32x16 o[4] = {};
    const int sr = tid >> 4, sc = (tid & 15) * 8, vst0 = v_st(sr, sc), vst1 = v_st(32 + sr, sc), kws = KSWZ(sr, sc * 2);
    const int vb0 = (int)(uintptr_t)V_lds + v_rd_base(lane);
    const unsigned voffk0 = (unsigned)(sr * LDQ + sc) * 2u, voffk1 = voffk0 + 32u * LDQ * 2u, voffq = (unsigned)(r32 * LDQ + hi * 8) * 2u, voffo = (unsigned)(4 * hi * LDO + r32) * 2u;
    const bf16* Kh = cur.K; const bf16* Vh = cur.V; const float* Bh = cur.Bias;
#define RESC(a) do { if (__any((a) < 1.f)) { if (hi == 0) al_l[r32] = (a); asm volatile("s_waitcnt lgkmcnt(0)" ::: "memory");              \
                     for (int d_ = 0; d_ < 4; ++d_) for (int r = 0; r < 16; ++r) o[d_][r] *= al_l[crow(r, hi)]; } } while (0)
#define KBASE(t) ((NT - 1 - (t)) * KVBLK)
#define MASKT(P0_, P1_, t) do { const int kb_ = KBASE(t); if (kb_ + KVBLK - 1 > qlo) mask_tile(P0_, P1_, qm - kb_, (unsigned)W); } while (0)
    constexpr int NQL = 8;
#define SEAM_K0() do { VMWN(NQL); SWRITE_HK(0); SBAR(); } while (0)
    f32x16 pA0, pA1, pB0, pB1; float mnA, mnB, alA, alB; bf16x8 pa0, pa1, pa2, pa3;
    { if (tid < NT * 16) { const f32x4 bv = *(const f32x4*)(Bh + 4 * tid); *(f32x4*)(bias_lds + 4 * tid) = bv; } __syncthreads(); }
    SWRITE_HV(0); SBAR();
    if (NT > 1) { SLOAD_H(Kh, Vh, Bh, KBASE(1)); }
    SBAR(); qkt<0>(pA0, pA1, K_lds, bias_lds + KBASE(0), r32, hi, S.qr);
    MASKT(pA0, pA1, 0); partialSM(pA0, pA1, m_reg, mnA, alA);
    if (NT > 1) { VMW(); SWRITE_H(1); }
    __syncthreads();
#define HALF_STEP(PX0, PX1, mnX, alX, PY0, PY1, alY, t, KB, VB, SB) do {                                                      \
        SBAR(); qkt<KB>(PX0, PX1, K_lds, bias_lds + KBASE(t), r32, hi, S.qr);                                             \
        finishSM(PY0, PY1, alY, l_reg, pa0, pa1, pa2, pa3); SBAR();                                                           \
        if ((t) + 1 < NT) { SLOAD_H(Kh, Vh, Bh, KBASE((t) + 1)); SBAR(); }                                               \
        pv_tile<VB>(o, vb0, pa0, pa1, pa2, pa3); MASKT(PX0, PX1, (t)); partialSM(PX0, PX1, m_reg, mnX, alX);                                        \
        __syncthreads();                                                                                                      \
        if ((t) + 1 < NT) { VMW(); SWRITE_H(SB); }                                                                          \
        RESC(alX); __syncthreads(); } while (0)
    for (int t = 1; t + 1 < NT; t += 2) {
        HALF_STEP(pB0, pB1, mnB, alB, pA0, pA1, alA, t, 1, 0, 0);
        HALF_STEP(pA0, pA1, mnA, alA, pB0, pB1, alB, t + 1, 0, 1, 1);
    }
    const bool even = (NT & 1) == 0;
    if (even) { SBAR(); qkt<1>(pB0, pB1, K_lds, bias_lds + KBASE(NT - 1), r32, hi, S.qr); SBAR(); }
    SLOAD_H(nxt.K, nxt.V, nxt.Bias, ((nxt.P0 + QB - 1) / KVBLK) * KVBLK); SBAR();
#pragma unroll
    for (int d0 = 0; d0 < 8; ++d0) S.qr[d0] = load8((const bf16*)((const char*)(nxt.Q + (size_t)(wid * QBLK) * LDQ) + voffq) + d0 * 16);
    SBAR();
    finishSM(pA0, pA1, alA, l_reg, pa0, pa1, pa2, pa3); SBAR();
    pv_tile<0>(o, vb0, pa0, pa1, pa2, pa3);
    if (even) { MASKT(pB0, pB1, NT - 1); partialSM(pB0, pB1, m_reg, mnB, alB); __syncthreads(); RESC(alB);
        finishSM(pB0, pB1, alB, l_reg, pa0, pa1, pa2, pa3); SBAR(); pv_tile<1>(o, vb0, pa0, pa1, pa2, pa3); }
    SBAR(); SEAM_K0();
    if (hi == 0) li_l[r32] = l_reg; asm volatile("s_waitcnt lgkmcnt(0)" ::: "memory");
    float rli[16];
#pragma unroll
    for (int r = 0; r < 16; ++r) rli[r] = __builtin_amdgcn_rcpf(li_l[crow(r, hi)]);
    char* Ob = (char*)(cur.O + (size_t)(wid * QBLK) * LDO);
#pragma unroll
    for (int r = 0; r < 16; ++r) { char* Orow = Ob + (size_t)(((r & 3) + 8 * (r >> 2)) * LDO) * 2;
#pragma unroll
        for (int d0 = 0; d0 < 4; ++d0) { const float v = o[d0][r] * rli[r];
            const float vn = __builtin_bit_cast(float, __builtin_amdgcn_mov_dpp(__builtin_bit_cast(int, v), 0xB1, 0xf, 0xf, true));
            if ((r32 & 1) == 0) *(unsigned*)(Orow + voffo + d0 * 64) = cvtpk(v, vn); } }
    __syncthreads();
#undef RESC
#undef KBASE
#undef MASKT
#undef SEAM_K0
#undef HALF_STEP
}
#undef GROW
#undef VMW
#undef VMWN
#undef SLOAD_H
#undef SWRITE_HK
#undef SWRITE_HV
#undef SWRITE_H
#undef SBAR
}

constexpr size_t MiB = 1u << 20;
constexpr size_t WS_WINE = 1 * MiB;
constexpr size_t WS_WOUTE = WS_WINE + 12 * MiB;
constexpr size_t WS_WINO = WS_WOUTE + 8 * MiB;
constexpr size_t WS_WOUTO = WS_WINO + 25 * MiB;
constexpr size_t WS_WUP = WS_WOUTO + 8 * MiB;
constexpr size_t WS_WDOWN = WS_WUP + 88 * MiB;
constexpr size_t WS_WPOOL = WS_WDOWN + 44 * MiB;
constexpr size_t WS_WSP = WS_WPOOL + 512 * 1024;
constexpr size_t WS_SS = WS_WSP + 512 * 1024;
constexpr size_t WS_XB = WS_SS + 1 * MiB;
constexpr size_t WS_SH = WS_XB + 128 * MiB;
constexpr size_t WS_Z = WS_SH;
constexpr size_t WS_MIX = WS_Z + 192 * MiB;
constexpr size_t WS_DP = WS_MIX + 128 * MiB;
constexpr size_t WS_ACT = WS_SH;
constexpr size_t WS_RAW = WS_ACT + 352 * MiB;
constexpr size_t WS_QKV = WS_SH;
constexpr size_t WS_ATT = WS_QKV + 384 * MiB;
constexpr size_t WS_LF = WS_ATT + 128 * MiB;
constexpr size_t WS_CB = WS_LF + 2 * MiB;
constexpr size_t WS_END = WS_CB + 2 * MiB;
static_assert(WS_END <= 1024 * MiB && WS_RAW + 88 * MiB <= WS_END && WS_DP + 64 * MiB <= WS_END, "d_ws map");

#ifndef PHASE_MASK
#define PHASE_MASK 0xffffffffu
#endif
#define PH(n) if constexpr (((PHASE_MASK) >> (n)) & 1u)
constexpr int REP_P0 = 1, REP_P1 = 1, REP_P2 = 1, REP_UP = 1, REP_ATT = 1;
constexpr int NWAVES = 8;
constexpr int LDS_BYTES = 139264;

struct Args { const float* in[19]; float* out; unsigned char* ws; };
#define GAS __attribute__((address_space(1)))
#define CAS __attribute__((address_space(4)))
__device__ __forceinline__ const float* karg_f(int i) {
    const CAS unsigned long long* ka = (const CAS unsigned long long*)__builtin_amdgcn_kernarg_segment_ptr(); asm volatile("" : "+s"(ka));
    return (const float*)(GAS const float*)ka[i];
}
#define IN(i) karg_f(i)

template <int CTRL> __device__ __forceinline__ float dpp_rd(float v) { return __builtin_bit_cast(float, __builtin_amdgcn_mov_dpp(__builtin_bit_cast(int, v), CTRL, 0xf, 0xf, true)); }
__device__ __forceinline__ float wave_sum(float v) {
    v += dpp_rd<0xB1>(v); v += dpp_rd<0x4E>(v); v += dpp_rd<0x141>(v); v += dpp_rd<0x140>(v);
    return rows_sum(v);
}
struct TrItem { const float* W; const float* g; bf16_t* WT; int ldw, nvalid, K, k0, n0src, n0dst; };
__device__ __forceinline__ void tr_load(const TrItem& t, f32x4 (&v)[8], float (&gs)[8], int lane) {
    const int n = t.n0src + 4 * (lane & 7); const bool ok = n < t.nvalid;
#pragma unroll
    for (int i = 0; i < 8; ++i) { const int kk = 8 * i + (lane >> 3);
        v[i] = ok ? *(const f32x4*)(t.W + (size_t)(t.k0 + kk) * t.ldw + n) : (f32x4){0.f, 0.f, 0.f, 0.f};
        gs[i] = t.g ? t.g[t.k0 + kk] : 1.0f; }
}
__device__ __forceinline__ void tr_finish(const TrItem& t, const f32x4 (&v)[8], const float (&gs)[8], LAS float* scr, int lane) {
#pragma unroll
    for (int i = 0; i < 8; ++i) { const int kk = 8 * i + (lane >> 3); LAS float* d = scr + kk * 33 + 4 * (lane & 7);
        d[0] = v[i][0] * gs[i]; d[1] = v[i][1] * gs[i]; d[2] = v[i][2] * gs[i]; d[3] = v[i][3] * gs[i]; }
    asm volatile("s_waitcnt lgkmcnt(0)" ::: "memory");
    const int c = lane & 7;
#pragma unroll
    for (int j = 0; j < 4; ++j) { const int n = (lane >> 3) + 8 * j; const LAS float* s = scr + (8 * c) * 33 + n;
        u32x4 o; o.x = cvt_pk_bf16(s[0 * 33], s[1 * 33]); o.y = cvt_pk_bf16(s[2 * 33], s[3 * 33]); o.z = cvt_pk_bf16(s[4 * 33], s[5 * 33]); o.w = cvt_pk_bf16(s[6 * 33], s[7 * 33]);
        *(u32x4*)(t.WT + (size_t)(t.n0dst + n) * t.K + t.k0 + 8 * c) = o; }
    asm volatile("s_waitcnt lgkmcnt(0)" ::: "memory");
}
#define XB_TMO      128
#define XB_XCNT(j)  (256  + 64 * (j))
#define XB_XSUB(j)  (1280 + 64 * (j))
#define XB_XGEN(j)  (2304 + 64 * (j))
#define XB_TOP      3328
#define XB_TOPGEN   3392
#define XCD_BAR_WORDS 3456
#define XB_SPIN_CAP (1u << 22)
__device__ __forceinline__ unsigned xb_ld(unsigned* p)              { return __hip_atomic_load(p, __ATOMIC_RELAXED, __HIP_MEMORY_SCOPE_AGENT); }
__device__ __forceinline__ unsigned xb_add(unsigned* p, unsigned v) { return __hip_atomic_fetch_add(p, v, __ATOMIC_RELAXED, __HIP_MEMORY_SCOPE_AGENT); }
__device__ __forceinline__ unsigned xb_xcc_id() { return (unsigned)__builtin_amdgcn_s_getreg((3 << 11) | 20) & 0xFu; }
#define XB_SPIN(cond, bar) do { unsigned _sp = 0; while (cond) { __builtin_amdgcn_s_sleep(1); \
    if ((++_sp & 255u) == 0u) { if (xb_ld(&(bar)[XB_TMO])) break; if (_sp > XB_SPIN_CAP) { atomicAdd(&(bar)[XB_TMO], 1u); break; } } } } while (0)
__device__ __forceinline__ void xcd_barrier_complete(unsigned* bar, unsigned x, unsigned& nloc, unsigned& nx) {
    const unsigned G = gridDim.x * gridDim.y * gridDim.z;
    unsigned sum, cnt, mine, sp = 0u;
    for (;;) {
        sum = 0u; cnt = 0u; mine = 0u;
#pragma unroll
        for (unsigned j = 0; j < 16; ++j) { const unsigned c = xb_ld(&bar[XB_XCNT(j)]); sum += c; cnt += (c > 0u) ? 1u : 0u; mine = (j == x) ? c : mine; }
        if (sum == G) break;
        __builtin_amdgcn_s_sleep(1);
        if ((++sp & 255u) == 0u) { if (xb_ld(&bar[XB_TMO])) break; if (sp > XB_SPIN_CAP) { atomicAdd(&bar[XB_TMO], 1u); break; } }
    }
    nloc = mine > 0u ? mine : 1u; nx = cnt > 0u ? cnt : 1u;
}
__device__ __forceinline__ void grid_bar(unsigned* bar, volatile LAS unsigned* st, int wave_s) {
    asm volatile("s_waitcnt vmcnt(0)" ::: "memory");
    __syncthreads();
    if (wave_s == 0) { if (lane_id() == 0) {
        __builtin_amdgcn_s_waitcnt(0);
        const unsigned x = xb_xcc_id();
        unsigned nloc = st[0], nx = st[1];
        if (nloc == 0u) { xcd_barrier_complete(bar, x, nloc, nx); st[0] = nloc; st[1] = nx; }
        const unsigned old = xb_add(&bar[XB_XSUB(x)], 1u);
        const unsigned gen = old / nloc;
        if (old + 1u == (gen + 1u) * nloc) {
            __builtin_amdgcn_fence(__ATOMIC_RELEASE, "agent");
            asm volatile("s_waitcnt vmcnt(0)" ::: "memory");
            const unsigned og = xb_add(&bar[XB_TOP], 1u);
            const unsigned tg = og / nx;
            if (og + 1u == (tg + 1u) * nx) xb_add(&bar[XB_TOPGEN], 1u);
            else XB_SPIN(xb_ld(&bar[XB_TOPGEN]) == tg, bar);
            __builtin_amdgcn_fence(__ATOMIC_ACQUIRE, "agent");
            xb_add(&bar[XB_XGEN(x)], 1u);
            asm volatile("s_waitcnt vmcnt(0)" ::: "memory");
        } else {
            XB_SPIN(xb_ld(&bar[XB_XGEN(x)]) == gen, bar);
            __builtin_amdgcn_fence(__ATOMIC_ACQUIRE, "agent");
            asm volatile("s_waitcnt vmcnt(0)" ::: "memory");
        }
    } }
    __syncthreads();
}
__global__ void __launch_bounds__(NWAVES * 64, 2) mega_fwd(Args args) {
    extern __shared__ __attribute__((aligned(16))) unsigned char lds[];
    cg::grid_group grid = cg::this_grid();
    const int wave_s = __builtin_amdgcn_readfirstlane((int)threadIdx.x >> 6);
#define PHASE_IDS int lane = lane_id(); asm volatile("" : "+v"(lane)); int wave = wave_s; asm volatile("" : "+s"(wave)); const int tid = wave * 64 + lane; (void)tid
    const int G = gridDim.x, bx = blockIdx.x;
    { if (threadIdx.x < 16) ((LAS unsigned*)((LAS unsigned char*)lds + LDS_BYTES - 64))[threadIdx.x] = 0u; __syncthreads();
      if (threadIdx.x == 0) (void)xb_add((unsigned*)karg_f(20) + XB_XCNT(xb_xcc_id()), 1u); }
#define GBAR() grid_bar((unsigned*)karg_f(20), (volatile LAS unsigned*)((LAS unsigned char*)lds + LDS_BYTES - 64), wave_s)
#define WSPTRS unsigned char* ws = (unsigned char*)karg_f(20); const float* x = IN(0); float* R = (float*)karg_f(19); \
    bf16_t* WinE = (bf16_t*)(ws + WS_WINE); bf16_t* WoutE = (bf16_t*)(ws + WS_WOUTE); bf16_t* WinO = (bf16_t*)(ws + WS_WINO); bf16_t* WoutO = (bf16_t*)(ws + WS_WOUTO); \
    bf16_t* Wup = (bf16_t*)(ws + WS_WUP); bf16_t* Wdown = (bf16_t*)(ws + WS_WDOWN); bf16_t* Wpool = (bf16_t*)(ws + WS_WPOOL); bf16_t* Wsp = (bf16_t*)(ws + WS_WSP); \
    float* SS = (float*)(ws + WS_SS); bf16_t* XB = (bf16_t*)(ws + WS_XB); \
    bf16_t* Z = (bf16_t*)(ws + WS_Z); bf16_t* MIX = (bf16_t*)(ws + WS_MIX); bf16_t* DP = (bf16_t*)(ws + WS_DP); \
    bf16_t* ACT = (bf16_t*)(ws + WS_ACT); float* RAW = (float*)(ws + WS_RAW); \
    bf16_t* QKV = (bf16_t*)(ws + WS_QKV); bf16_t* ATT = (bf16_t*)(ws + WS_ATT); float* LF = (float*)(ws + WS_LF); float* CB = (float*)(ws + WS_CB); \
    (void)x; (void)R; (void)WinE; (void)WoutE; (void)WinO; (void)WoutO; (void)Wup; (void)Wdown; (void)Wpool; (void)Wsp; (void)SS; (void)XB; (void)Z; (void)MIX; (void)DP; (void)ACT; (void)RAW; (void)QKV; (void)ATT; (void)LF; (void)CB
    LAS unsigned char* ldsl = (LAS unsigned char*)lds;

    for (int rep_ = 0; rep_ < REP_P0; ++rep_) { if (rep_) GBAR();
    PH(0) {
        PHASE_IDS; WSPTRS;
        LAS float* scr = (LAS float*)(ldsl + wave * 8448);
        const int gw = bx * NWAVES + wave, NGW = G * NWAVES;
        constexpr int I_INE = 32 * 96, I_SQ = 32 * 64, I_POOL = 0, I_INO = 32 * 193, I_UP = 32 * 352, I_DN = 88 * 64;
        constexpr int NITEMS = I_INE + I_SQ + I_POOL + I_INO + I_SQ + 2 * I_UP + 2 * I_DN;
        auto decode = [&](int it) { TrItem t; int r = it;
            if (r < I_INE) { const int kb = r / 96, nb = r % 96; t = TrItem{IN(4), IN(1), WinE, EVEN_IN, EVEN_IN, DM, 64 * kb, 32 * nb, 32 * nb}; return t; } r -= I_INE;
            if (r < I_SQ) { const int kb = r / 64, nb = r % 64; t = TrItem{IN(11), nullptr, WoutE, DM, DM, DM, 64 * kb, 32 * nb, 32 * nb}; return t; } r -= I_SQ;
            if (r < I_POOL) { const int j = r / 32, rr = r % 32, kb = rr / 8, nb = rr % 8; t = TrItem{IN(9) + j * 65536, nullptr, Wpool + j * 65536, 256, 256, 256, 64 * kb, 32 * nb, 32 * nb}; return t; } r -= I_POOL;
            if (r < I_INO) { const int kb = r / 193, nb = r % 193; t = TrItem{IN(12), IN(1) + DM, WinO, ODD_IN, ODD_IN, DM, 64 * kb, 32 * nb, 32 * nb}; return t; } r -= I_INO;
            if (r < I_SQ) { const int kb = r / 64, nb = r % 64; t = TrItem{IN(14), nullptr, WoutO, DM, DM, DM, 64 * kb, 32 * nb, 32 * nb}; return t; } r -= I_SQ;
            if (r < 2 * I_UP) { const int l = r / I_UP, rr = r % I_UP, kb = rr / 352, nb = rr % 352; const int n0 = 32 * nb;
                const int nd = n0 < DFF ? (n0 >> 7) * 256 + (n0 & 127) : ((n0 - DFF) >> 7) * 256 + 128 + ((n0 - DFF) & 127);
                t = TrItem{IN(15) + (size_t)l * DM * NUP, IN(2) + l * DM, Wup + (size_t)l * NUP * DM, NUP, NUP, DM, 64 * kb, n0, nd}; return t; } r -= 2 * I_UP;
            { const int l = r / I_DN, rr = r % I_DN, kb = rr / 64, nb = rr % 64;
                t = TrItem{IN(18) + (size_t)l * DFF * DM, nullptr, Wdown + (size_t)l * DM * DFF, DM, DM, DFF, 64 * kb, 32 * nb, 32 * nb}; return t; } };
        {
            int it = gw; TrItem cur; f32x4 va[8], vb[8]; float ga[8], gb[8];
            if (it < NITEMS) { cur = decode(it); tr_load(cur, va, ga, lane); }
            while (it < NITEMS) {
                const int nit = it + NGW; TrItem nx = cur;
                if (nit < NITEMS) { nx = decode(nit); tr_load(nx, vb, gb, lane); }
                tr_finish(cur, va, ga, scr, lane);
                cur = nx; it = nit;
#pragma unroll
                for (int i = 0; i < 8; ++i) { va[i] = vb[i]; ga[i] = gb[i]; }
            }
        }
        for (int i = bx * 512 + tid; i < 4 * 128 * 128; i += G * 512) { const int t = (i >> 7) & 127, s = i & 127; const float v = ((t >> 6) >= (s >> 6)) ? IN(7)[i] : 0.f; Wsp[i] = (bf16_t)(cvt_pk_bf16(v, 0.f) & 0xffffu); }
        for (int i = bx * 512 + tid; i < 4 * 256 * 256; i += G * 512) { const float v = IN(9)[i] * IN(10)[((i >> 16) << 8) + (i & 255)]; Wpool[i] = (bf16_t)(cvt_pk_bf16(v, 0.f) & 0xffffu); }
        for (int i = bx * 512 + tid; i < 4 * MTOK; i += G * 512) SS[MTOK + i] = 0.f;
        for (int m = gw; m < MTOK; m += 2 * NGW) {
            const int m1 = (m + NGW < MTOK) ? m + NGW : m;
            const f32x4* xr0 = (const f32x4*)(x + (size_t)m * DM) + lane; const f32x4* xr1 = (const f32x4*)(x + (size_t)m1 * DM) + lane; f32x4 v0[8], v1[8]; float s0 = 0.f, s1 = 0.f;
#pragma unroll
            for (int j = 0; j < 8; ++j) { v0[j] = xr0[64 * j]; v1[j] = xr1[64 * j]; }
#pragma unroll
            for (int j = 0; j < 8; ++j) { s0 += (v0[j][0] * v0[j][0] + v0[j][1] * v0[j][1]) + (v0[j][2] * v0[j][2] + v0[j][3] * v0[j][3]); s1 += (v1[j][0] * v1[j][0] + v1[j][1] * v1[j][1]) + (v1[j][2] * v1[j][2] + v1[j][3] * v1[j][3]); }
            s0 = wave_sum(s0); s1 = wave_sum(s1);
            u32x2* o0 = (u32x2*)(XB + (size_t)m * DM) + lane; u32x2* o1 = (u32x2*)(XB + (size_t)m1 * DM) + lane;
#pragma unroll
            for (int j = 0; j < 8; ++j) { u32x2 w; w.x = cvt_pk_bf16(v0[j][0], v0[j][1]); w.y = cvt_pk_bf16(v0[j][2], v0[j][3]); o0[64 * j] = w;
                u32x2 w1; w1.x = cvt_pk_bf16(v1[j][0], v1[j][1]); w1.y = cvt_pk_bf16(v1[j][2], v1[j][3]); o1[64 * j] = w1; }
            if (lane == 0) { SS[m] = s0; SS[m1] = s1; }
        }
    }
    }
    grid.sync();

    for (int rep_ = 0; rep_ < REP_P1; ++rep_) { if (rep_) GBAR();
    PH(1) {
        WSPTRS;
        {
            pg8::Gemm gw_{WoutE + 1024, Wpool, DM, 256, 256, 512}; pg8::StaticOrder Sw; Sw.init(DM, 1024, G, bx);
            pg8::EpiPool Ew{WoutE, DM, 1024, nullptr};
            pg8::gemm_phase<pg8::EpiPool, pg8::StaticOrder, true, true>(ldsl, gw_, Sw, Ew, wave_s);
        }
        pg8::Gemm g{XB, WinE, DM, DM, DM, 0}; pg8::StaticOrder S; S.init(MTOK, EVEN_IN, G, bx);
        pg8::EpiZ<false> E{Z, EVEN_IN, SS, 8, -1, nullptr, nullptr};
        pg8::gemm_phase<pg8::EpiZ<false>, pg8::StaticOrder, true, true>(ldsl, g, S, E, wave_s);
    }
    }
    GBAR();

    for (int rep_ = 0; rep_ < REP_P2; ++rep_) { if (rep_) GBAR();
    PH(2) {
        PHASE_IDS; WSPTRS;
        constexpr int VT_LD = 136, OFF_W = 256 * VT_LD * 2;
        const int fr = lane & 15, fq = lane >> 4;
        for (int unit = bx; unit < 1024; unit += G) {
            const int g = unit & 3, blk = unit >> 2; const int row0 = blk * 128;
            { const int t = tid >> 2, c0 = (tid & 3) * 32;
#pragma unroll
              for (int j = 0; j < 4; ++j) { const u32x4 w = *(const u32x4*)(Wsp + (size_t)g * 16384 + t * 128 + c0 + j * 8); *(LAS u32x4*)(ldsl + OFF_W + (t * VT_LD + c0 + j * 8) * 2) = w; } }
            { const float* lg = IN(5) + g * 256 + 4 * lane; const float* lb = IN(6) + g * 256 + 4 * lane;
              const f32x4 lgv = *(const f32x4*)lg, lbv = *(const f32x4*)lb;
              u32x2 wv[16];
#pragma unroll
              for (int r = 0; r < 16; ++r) wv[r] = *(const u32x2*)(Z + (size_t)(row0 + 16 * wave + r) * EVEN_IN + 1024 + g * 256 + 4 * lane);
#pragma unroll
              for (int pr = 0; pr < 8; ++pr) { const int s = 16 * wave + 2 * pr;
                  const u32x2 w0 = wv[2 * pr], w1 = wv[2 * pr + 1];
                  f32x4 a = (f32x4){bflo(w0.x), bfhi(w0.x), bflo(w0.y), bfhi(w0.y)}, b = (f32x4){bflo(w1.x), bfhi(w1.x), bflo(w1.y), bfhi(w1.y)};
                  const float ma = wave_sum((a[0] + a[1]) + (a[2] + a[3])) * (1.f / 256.f), mb = wave_sum((b[0] + b[1]) + (b[2] + b[3])) * (1.f / 256.f);
                  a = a - ma; b = b - mb;
                  const float va = wave_sum((a[0] * a[0] + a[1] * a[1]) + (a[2] * a[2] + a[3] * a[3])) * (1.f / 256.f), vb = wave_sum((b[0] * b[0] + b[1] * b[1]) + (b[2] * b[2] + b[3] * b[3])) * (1.f / 256.f);
                  const float ra = __builtin_amdgcn_rsqf(va + EPS), rb = __builtin_amdgcn_rsqf(vb + EPS);
                  a = a * ra * lgv + lbv; b = b * rb * lgv + lbv;
#pragma unroll
                  for (int e = 0; e < 4; ++e) *(LAS unsigned*)(ldsl + ((4 * lane + e) * VT_LD + s) * 2) = cvt_pk_bf16(a[e], b[e]);
              } }
            __syncthreads();
            f32x4 acc[8][2];
#pragma unroll
            for (int mt = 0; mt < 8; ++mt) { acc[mt][0] = (f32x4){0.f, 0.f, 0.f, 0.f}; acc[mt][1] = acc[mt][0]; }
#pragma unroll
            for (int ks = 0; ks < 4; ++ks) {
                bf16x8 bfr[2];
#pragma unroll
                for (int nn = 0; nn < 2; ++nn) bfr[nn] = *(const LAS bf16x8*)(ldsl + ((32 * wave + 16 * nn + fr) * VT_LD + 32 * ks + 8 * fq) * 2);
#pragma unroll
                for (int mt = 0; mt < 8; ++mt) { const bf16x8 afr = *(const LAS bf16x8*)(ldsl + OFF_W + ((16 * mt + fr) * VT_LD + 32 * ks + 8 * fq) * 2);
                    acc[mt][0] = __builtin_amdgcn_mfma_f32_16x16x32_bf16(bfr[0], afr, acc[mt][0], 0, 0, 0);
                    acc[mt][1] = __builtin_amdgcn_mfma_f32_16x16x32_bf16(bfr[1], afr, acc[mt][1], 0, 0, 0); }
            }
            u32x2 uwv[8][2]; float biasv[8];
#pragma unroll
            for (int mt = 0; mt < 8; ++mt) { const int t = 16 * mt + fr; biasv[mt] = IN(8)[g * 128 + t];
#pragma unroll
                for (int nn = 0; nn < 2; ++nn) uwv[mt][nn] = *(const u32x2*)(Z + (size_t)(row0 + t) * EVEN_IN + g * 256 + 32 * wave + 16 * nn + 4 * fq); }
            asm volatile("" ::: "memory");
#pragma unroll
            for (int mt = 0; mt < 8; ++mt) { const int t = 16 * mt + fr; const float bias = biasv[mt];
#pragma unroll
                for (int nn = 0; nn < 2; ++nn) { const int d = 32 * wave + 16 * nn + 4 * fq; const size_t row = (size_t)(row0 + t);
                    const u32x2 uw = uwv[mt][nn]; const f32x4 gt = acc[mt][nn] + bias;
                    u32x2 w; w.x = cvt_pk_bf16(bflo(uw.x) * gt[0], bfhi(uw.x) * gt[1]); w.y = cvt_pk_bf16(bflo(uw.y) * gt[2], bfhi(uw.y) * gt[3]);
                    *(u32x2*)(MIX + row * DM + g * 256 + d) = w; } }
            __syncthreads();
        }
        for (int item = bx * 512 + tid; item < 1024 * 128; item += G * 512) {
            const int cc = item & 127, run = item >> 7; const int c0 = cc * 8; const int w = 2 << (c0 >> 8);
            const int rowa = run * 32, pos0 = rowa & (SEQ - 1);
            const bf16_t* P = Z + 2048 + c0; float s[8];
#pragma unroll
            for (int e = 0; e < 8; ++e) s[e] = 0.f;
            for (int j = 1; j <= w; ++j) if (pos0 - j >= 0) { const u32x4 v = *(const u32x4*)(P + (size_t)(rowa - j) * EVEN_IN);
                s[0] += bflo(v.x); s[1] += bfhi(v.x); s[2] += bflo(v.y); s[3] += bfhi(v.y); s[4] += bflo(v.z); s[5] += bfhi(v.z); s[6] += bflo(v.w); s[7] += bfhi(v.w); }
            for (int i0 = 0; i0 < 32; i0 += 8) {
                u32x4 pv[8], qv[8];
#pragma unroll
                for (int j = 0; j < 8; ++j) { const int row = rowa + i0 + j, pos = pos0 + i0 + j;
                    pv[j] = *(const u32x4*)(P + (size_t)row * EVEN_IN);
                    qv[j] = (pos - w >= 0) ? *(const u32x4*)(P + (size_t)(row - w) * EVEN_IN) : (u32x4){0u, 0u, 0u, 0u}; }
#pragma unroll
                for (int j = 0; j < 8; ++j) { const int row = rowa + i0 + j, pos = pos0 + i0 + j;
                    const u32x4 v = pv[j], q = qv[j]; float p[8] = {bflo(v.x), bfhi(v.x), bflo(v.y), bfhi(v.y), bflo(v.z), bfhi(v.z), bflo(v.w), bfhi(v.w)};
                    const float qq[8] = {bflo(q.x), bfhi(q.x), bflo(q.y), bfhi(q.y), bflo(q.z), bfhi(q.z), bflo(q.w), bfhi(q.w)};
#pragma unroll
                    for (int e = 0; e < 8; ++e) s[e] += p[e] - qq[e];
                    const float inv = 1.f / (float)((pos + 1) < w ? (pos + 1) : w);
                    u32x4 o; o.x = cvt_pk_bf16(s[0] * inv - p[0], s[1] * inv - p[1]); o.y = cvt_pk_bf16(s[2] * inv - p[2], s[3] * inv - p[3]);
                    o.z = cvt_pk_bf16(s[4] * inv - p[4], s[5] * inv - p[5]); o.w = cvt_pk_bf16(s[6] * inv - p[6], s[7] * inv - p[7]);
                    *(u32x4*)(MIX + (size_t)row * DM + 1024 + c0) = o; }
            }
        }
    }
    }
    GBAR();

    PH(4) {
        WSPTRS;
        pg8::Gemm g{MIX, WoutE, DM, DM, DM, 0}; pg8::StaticOrder S; S.init(MTOK, DM, G, bx, 4);
        pg8::EpiRes<true> E{nullptr, XB, nullptr, XB, SS + MTOK};
        pg8::gemm_phase<pg8::EpiRes<true>, pg8::StaticOrder, true, true>(ldsl, g, S, E, wave_s);
    }
    GBAR();

#pragma unroll
    for (int layer = 0; layer < 2; ++layer) {
        if (layer == 1) {
            PH(5) {
                WSPTRS;
                pg8::Gemm g{XB, WinO, DM, DM, DM, 0}; pg8::StaticOrder S; S.init(MTOK, QKV_LD, G, bx);
                pg8::EpiZ<false> E{QKV, QKV_LD, SS + 2 * MTOK, 0, -1, nullptr, nullptr};
                pg8::gemm_phase<pg8::EpiZ<false>, pg8::StaticOrder, true, true>(ldsl, g, S, E, wave_s);
                { PHASE_IDS; const int fr = lane & 15, fq = lane >> 4;
                  for (int rb = bx * 128 + wave * 16; rb < MTOK; rb += G * 128) {
                      const bf16_t* ap = XB + (size_t)(rb + fr) * DM + 8 * fq; const bf16_t* bp = WinO + (size_t)(QKV_LD + fr) * DM + 8 * fq;
                      f32x4 acc = (f32x4){0.f, 0.f, 0.f, 0.f};
#pragma unroll 8
                      for (int k = 0; k < DM; k += 32) { const bf16x8 a = *(const bf16x8*)(ap + k), b = *(const bf16x8*)(bp + k);
                          acc = __builtin_amdgcn_mfma_f32_16x16x32_bf16(b, a, acc, 0, 0, 0); }
                      const float rs = __builtin_amdgcn_rsqf((SS + 2 * MTOK)[rb + fr] * (1.0f / DM) + EPS);
                      *(f32x4*)(LF + (size_t)(rb + fr) * 16 + 4 * fq) = acc * rs; } }
            }
            GBAR();
            PH(6) { PHASE_IDS; WSPTRS; if (wave == 0) {
                for (int bh = bx; bh < NB * NHEAD; bh += G) { const int b = bh >> 4, h = bh & 15;
                    const float* src = LF + ((size_t)b * SEQ + 32 * lane) * 16 + h; float v[32]; float run = 0.f; const float bf = IN(13)[h];
#pragma unroll
                    for (int j = 0; j < 32; ++j) { const float xx = src[j * 16] + bf; run += fminf(xx, 0.f) - 0.6931471805599453f * __builtin_amdgcn_logf(1.0f + __builtin_amdgcn_exp2f(-1.4426950408889634f * fabsf(xx))); v[j] = run; }
                    float incl = run;
#pragma unroll
                    for (int o = 1; o < 64; o <<= 1) { const float t = __shfl_up(incl, o); if (lane >= o) incl += t; }
                    const float excl = incl - run; float* dst = CB + (size_t)bh * SEQ + 32 * lane;
#pragma unroll
                    for (int j = 0; j < 32; ++j) dst[j] = -(v[j] + excl) * (1.0f / fox::SCALE);
                }
            } }
            GBAR();
            for (int rep_ = 0; rep_ < REP_ATT; ++rep_) { if (rep_) GBAR();
            PH(7) {
                WSPTRS;
                const int total = NB * NHEAD * 4;
                if (bx < total) {
                    auto mkref = [&](int L, int pass) { const int bh = L >> 2, xq = L & 3; const int qb = pass ? 7 - xq : xq; const int b = bh >> 4, h = bh & 15;
                        fox::BlockRef r; const size_t rowb = (size_t)b * SEQ;
                        r.Q = (const fox::bf16*)QKV + (rowb + qb * 256) * QKV_LD + h * HD; r.K = (const fox::bf16*)QKV + rowb * QKV_LD + DM + h * HD; r.V = (const fox::bf16*)QKV + rowb * QKV_LD + 2 * DM + h * HD;
                        r.Bias = CB + (size_t)bh * SEQ; r.O = (fox::bf16*)ATT + (rowb + qb * 256) * DM + h * HD; r.P0 = qb * 256; return r; };
                    int L = bx, pass = 0; fox::BlockRef cur = mkref(L, 0); fox::Seam S;
                    fox::fox_prime(cur, (char*)lds, S, wave_s);
                    for (;;) {
                        const bool more_pass = pass == 0, more_item = L + G < total, last = !more_pass && !more_item;
                        int Ln = L, passn = pass + 1; if (!more_pass) { passn = 0; Ln = more_item ? L + G : L; }
                        const fox::BlockRef nxt = last ? cur : mkref(Ln, passn);
                        fox::fox_block(cur, nxt, (char*)lds, S, wave_s);
                        if (last) break;
                        cur = nxt; pass = passn; L = Ln;
                    }
                }
            }
            }
            GBAR();
            PH(8) {
                WSPTRS;
                pg8::Gemm g{ATT, WoutO, DM, DM, DM, 0}; pg8::StaticOrder S; S.init(MTOK, DM, G, bx, 4);
                pg8::EpiRes<true> E{nullptr, XB, nullptr, XB, SS + 3 * MTOK};
                pg8::gemm_phase<pg8::EpiRes<true>, pg8::StaticOrder, true, true>(ldsl, g, S, E, wave_s);
            }
            GBAR();
        }
        const float* cw = IN(16) + (size_t)layer * 3 * NUP; const float* cb = IN(17) + (size_t)layer * NUP;
        for (int rep_ = 0; rep_ < REP_UP; ++rep_) { if (rep_) GBAR();
        PH(9) {
            WSPTRS;
            pg8::Gemm g{XB, Wup + (size_t)layer * NUP * DM, DM, DM, DM, 0}; pg8::StaticOrder S; S.init(MTOK, NUP, G, bx);
            pg8::EpiUpConv E{ACT, RAW, SS + (size_t)(layer == 0 ? 1 : 3) * MTOK, cw, cb};
            pg8::gemm_phase<pg8::EpiUpConv, pg8::StaticOrder, true, true>(ldsl, g, S, E, wave_s);
        }
        }
        GBAR();
        PH(10) { PHASE_IDS; WSPTRS; for (int idx = bx * 512 + tid; idx < 512 * (DFF / 4); idx += G * 512) {
            const int sp = idx / (DFF / 4), c = 4 * (idx - sp * (DFF / 4)); const int rc = (c >> 7) * 256 + (c & 127); const bool first = (sp & 31) == 0;
            const float* Rr = RAW + (size_t)sp * 4 * NUP + rc; const float* Rp = Rr - 4 * NUP; const f32x4 z4 = (f32x4){0.f, 0.f, 0.f, 0.f};
            const f32x4 g0 = *(const f32x4*)Rr, g1 = *(const f32x4*)(Rr + NUP), v0 = *(const f32x4*)(Rr + 128), v1 = *(const f32x4*)(Rr + NUP + 128);
            const f32x4 gm1 = first ? z4 : *(const f32x4*)(Rp + 3 * NUP), gm2 = first ? z4 : *(const f32x4*)(Rp + 2 * NUP), vm1 = first ? z4 : *(const f32x4*)(Rp + 3 * NUP + 128), vm2 = first ? z4 : *(const f32x4*)(Rp + 2 * NUP + 128);
            const f32x4 wg0 = *(const f32x4*)(cw + c), wg1 = *(const f32x4*)(cw + NUP + c), wg2 = *(const f32x4*)(cw + 2 * NUP + c), bg = *(const f32x4*)(cb + c);
            const f32x4 wv0 = *(const f32x4*)(cw + DFF + c), wv1 = *(const f32x4*)(cw + NUP + DFF + c), wv2 = *(const f32x4*)(cw + 2 * NUP + DFF + c), bv = *(const f32x4*)(cb + DFF + c);
            const f32x4 cg0 = bg + wg0 * gm2 + wg1 * gm1 + wg2 * g0, cv0 = bv + wv0 * vm2 + wv1 * vm1 + wv2 * v0;
            const f32x4 cg1 = bg + wg0 * gm1 + wg1 * g0 + wg2 * g1, cv1 = bv + wv0 * vm1 + wv1 * v0 + wv2 * v1;
            u32x2 o0, o1;
            o0.x = cvt_pk_bf16(pg8::silu_f(cg0[0]) * cv0[0], pg8::silu_f(cg0[1]) * cv0[1]); o0.y = cvt_pk_bf16(pg8::silu_f(cg0[2]) * cv0[2], pg8::silu_f(cg0[3]) * cv0[3]);
            o1.x = cvt_pk_bf16(pg8::silu_f(cg1[0]) * cv1[0], pg8::silu_f(cg1[1]) * cv1[1]); o1.y = cvt_pk_bf16(pg8::silu_f(cg1[2]) * cv1[2], pg8::silu_f(cg1[3]) * cv1[3]);
            *(u32x2*)(ACT + (size_t)(sp * 64) * DFF + c) = o0; *(u32x2*)(ACT + (size_t)(sp * 64 + 1) * DFF + c) = o1;
        } }
        GBAR();
        PH(11) {
            WSPTRS;
            pg8::Gemm g{ACT, Wdown + (size_t)layer * DM * DFF, DFF, DFF, DFF, 0}; pg8::StaticOrder S; S.init(MTOK, DM, G, bx, 4);
            pg8::EpiRes<true> E{nullptr, XB, nullptr, XB, SS + (size_t)(layer == 0 ? 2 : 4) * MTOK};
            pg8::gemm_phase<pg8::EpiRes<true>, pg8::StaticOrder, true, true>(ldsl, g, S, E, wave_s);
        }
        GBAR();
    }
    PH(12) {
        PHASE_IDS; WSPTRS;
        const float* ss4 = SS + 4 * (size_t)MTOK; const float* gf = IN(3);
        const int c4 = tid; const f32x4 gv = ((const f32x4*)gf)[c4];
        for (int rb = bx * 16; rb < MTOK; rb += G * 16) {
            u32x2 v[16]; float rs[16];
#pragma unroll
            for (int j = 0; j < 16; ++j) { v[j] = ((const u32x2*)XB)[(size_t)(rb + j) * 512 + c4]; rs[j] = ss4[rb + j]; }
#pragma unroll
            for (int j = 0; j < 16; ++j) { const float r = __builtin_amdgcn_rsqf(rs[j] * (1.0f / DM) + EPS); const f32x4 xv = (f32x4){bflo(v[j].x), bfhi(v[j].x), bflo(v[j].y), bfhi(v[j].y)};
                ((f32x4*)R)[(size_t)(rb + j) * 512 + c4] = xv * r * gv; }
        }
    }
}

extern "C" void kernel_launch(void* const* d_in, const int* in_sizes, int n_in, void* d_out, int out_size, void* d_ws, size_t ws_size, hipStream_t stream) {
    static int grid = 0;
    if (grid == 0) {
        if (n_in != 19 || out_size != MTOK * DM || ws_size < WS_END) { fprintf(stderr, "kernel_launch: unexpected shapes (n_in %d out %d ws %zu)\n", n_in, out_size, ws_size); grid = -1; return; }
        int dev = 0, cus = 0, per_cu = 0;
        (void)hipGetDevice(&dev); (void)hipDeviceGetAttribute(&cus, hipDeviceAttributeMultiprocessorCount, dev);
        if (hipFuncSetAttribute((const void*)mega_fwd, hipFuncAttributeMaxDynamicSharedMemorySize, LDS_BYTES) != hipSuccess) { fprintf(stderr, "kernel_launch: hipFuncSetAttribute failed\n"); grid = -1; return; }
        if (hipOccupancyMaxActiveBlocksPerMultiprocessor(&per_cu, (const void*)mega_fwd, NWAVES * 64, LDS_BYTES) != hipSuccess || per_cu < 1) { fprintf(stderr, "kernel_launch: occupancy query gave %d\n", per_cu); per_cu = 1; }
        (void)hipGetLastError();
        grid = cus * 1;
    }
    if (grid < 0) return;
    if (hipMemsetAsync(d_ws, 0, 16384, stream) != hipSuccess) { fprintf(stderr, "kernel_launch: memset failed\n"); return; }
    Args a{};
    for (int i = 0; i < 19; ++i) a.in[i] = (const float*)d_in[i];
    a.out = (float*)d_out; a.ws = (unsigned char*)d_ws;
    void* params[] = {&a};
    hipError_t e = hipLaunchCooperativeKernel((const void*)mega_fwd, dim3(grid), dim3(NWAVES * 64), params, LDS_BYTES, stream);
    if (e != hipSuccess) fprintf(stderr, "kernel_launch: cooperative launch failed: %s (grid %d)\n", hipGetErrorString(e), grid);
}
```

```cpp
#include <hip/hip_runtime.h>
#include <hip/hip_bf16.h>
#include <hip/hip_cooperative_groups.h>
#include <cstdio>
#include <cstdint>
namespace cg = cooperative_groups;

#define LAS __attribute__((address_space(3)))
typedef unsigned short bf16_t;
typedef short bf16x8 __attribute__((ext_vector_type(8)));
typedef short s16x4 __attribute__((ext_vector_type(4)));
typedef float f32x4 __attribute__((ext_vector_type(4)));
typedef float f32x2 __attribute__((ext_vector_type(2)));
typedef float f32x16 __attribute__((ext_vector_type(16)));
typedef unsigned u32x4 __attribute__((ext_vector_type(4)));
typedef unsigned u32x2 __attribute__((ext_vector_type(2)));

constexpr int DM = 2048, NB = 16, SEQ = 2048, MTOK = NB * SEQ;
constexpr int DFF = 5632, NUP = 2 * DFF;
constexpr int EVEN_IN = 3072, ODD_IN = 6160, ODD_PAD = 6400, QKV_LD = 6144;
constexpr int NHEAD = 16, HD = 128;
constexpr float EPS = 1e-6f;

__device__ __forceinline__ unsigned cvt_pk_bf16(float lo, float hi) { unsigned r; asm volatile("v_cvt_pk_bf16_f32 %0, %1, %2" : "=v"(r) : "v"(lo), "v"(hi)); return r; }
__device__ __forceinline__ float bf2f(unsigned short h) { return __uint_as_float(((unsigned)h) << 16); }
__device__ __forceinline__ float bflo(unsigned w) { return __uint_as_float(w << 16); }
__device__ __forceinline__ float bfhi(unsigned w) { return __uint_as_float(w & 0xffff0000u); }

__device__ __forceinline__ int lane_id() { int l; asm volatile("v_mbcnt_lo_u32_b32 %0, -1, 0\n\tv_mbcnt_hi_u32_b32 %0, -1, %0" : "=v"(l)); return l; }
__device__ __forceinline__ float rows_sum(float v) {
    { auto r = __builtin_amdgcn_permlane16_swap(__float_as_uint(v), __float_as_uint(v), false, false); v = __uint_as_float(r[0]) + __uint_as_float(r[1]); }
    { auto r = __builtin_amdgcn_permlane32_swap(__float_as_uint(v), __float_as_uint(v), false, false); v = __uint_as_float(r[0]) + __uint_as_float(r[1]); }
    return v;
}
namespace pg8 {
constexpr int BM = 256, BK = 64, HALF = 128, HTB = HALF * BK * 2, STAGE_BYTES = 8 * HTB, NXCD = 8, WGM = 8;
__host__ __device__ __forceinline__ int lds_byte(int r, int c) { const int st = (r >> 4) * 2 + (c >> 5), rr = r & 15, cc = c & 31, ob = rr * 64 + cc * 2; return st * 1024 + (ob ^ (((ob >> 9) & 1) << 5)); }
__host__ __device__ __forceinline__ void stage_rc(int b, int& R, int& C) { const int st = b / 1024, sb = b % 1024, swz = sb ^ (((sb >> 9) & 1) << 5); R = (st >> 1) * 16 + swz / 64; C = (st & 1) * 32 + (swz % 64) / 2; }
__host__ __device__ __forceinline__ int perm32(int rho) { const int n = rho >> 4, i = rho & 15; return 8 * (i >> 2) + 4 * n + (i & 3); }

struct Unit { int pm, pn; };
struct Gemm { const bf16_t* A; const bf16_t* Bt; int lda, ldb, K; int a_pn_off; };

struct StaticOrder {
    int nM, nN, nwg, G, c;
    __host__ __device__ void init(int M, int N, int G_, int c_) { nM = M / BM; nN = N / BM; nwg = nM * nN; G = G_; c = c_; }
    __host__ __device__ bool next(int i, Unit& u) const {
        const long L = (long)i * G + c; if (L >= nwg) return false;
        int wgid = (int)L; { const int q = nwg / NXCD, r = nwg % NXCD, xcd = wgid % NXCD, off = wgid / NXCD; wgid = (xcd < r ? xcd * (q + 1) : r * (q + 1) + (xcd - r) * q) + off; }
        const int nig = WGM * nN, gid = wgid / nig, fm = gid * WGM, gsz = (nM - fm) < WGM ? (nM - fm) : WGM;
        u.pm = fm + ((wgid % nig) % gsz); u.pn = (wgid % nig) / gsz; return true;
    }
};

__device__ __forceinline__ f32x2 gelu_pk(f32x2 v) {
    const f32x2 av = __builtin_elementwise_abs(v), d = av * 0.2316418882f + 1.0f;
    f32x2 t; t.x = __builtin_amdgcn_rcpf(d.x); t.y = __builtin_amdgcn_rcpf(d.y);
    f32x2 q = t * 0.5307027145f + (-0.7265760135f); q = q * t + 0.7107068705f; q = q * t + (-0.142248368f); q = q * t + 0.127414796f; q = q * t;
    const f32x2 s = (v * v) * (-0.72134752044f);
    f32x2 e; e.x = __builtin_amdgcn_exp2f(s.x); e.y = __builtin_amdgcn_exp2f(s.y);
    const f32x2 m = v * (q * e), r = v - m;
    f32x2 o; o.x = v.x < 0.f ? m.x : r.x; o.y = v.y < 0.f ? m.y : r.y; return o;
}

__device__ __forceinline__ void load_rstd(float (&rs)[2][4], const float* ss, int rowbase) {
#pragma unroll
    for (int ai = 0; ai < 2; ++ai)
#pragma unroll
        for (int m = 0; m < 4; ++m) rs[ai][m] = __builtin_amdgcn_rsqf(ss[rowbase + ai * HALF + m * 16] * (1.0f / DM) + EPS);
}

template <bool HAS_LF> struct EpiZ {
    static constexpr bool PERM = true, PERMA = false, AFTER_DRAIN = false;
    bf16_t* O; int ldc; const float* ss; int gelu_tiles; int lf_tile; const float* bfg; float* LF;
    __device__ __forceinline__ void operator()(const f32x4 (&acc)[2][2][4][2], const Unit& u, int wr, int wc, int fr, int fq) const {
        const int row0 = u.pm * BM + wr * 64 + fr;
        float rs[2][4]; load_rstd(rs, ss, row0);
        if (HAS_LF && u.pn == lf_tile) {
            if (wc == 0 && fq < 2) {
#pragma unroll
                for (int ai = 0; ai < 2; ++ai)
#pragma unroll
                    for (int m = 0; m < 4; ++m) { const int row = row0 + ai * HALF + m * 16;
#pragma unroll
                        for (int n = 0; n < 2; ++n) { const f32x4 v = acc[ai][0][m][n] * rs[ai][m]; const int col = 8 * fq + 4 * n; f32x4 o;
#pragma unroll
                            for (int e = 0; e < 4; ++e) o[e] = v[e];
                            *(f32x4*)(LF + (size_t)row * 16 + col) = o; } }
            }
            return;
        }
        const int col0 = u.pn * BM + wc * 32 + 8 * fq; const bool act = u.pn < gelu_tiles;
#pragma unroll
        for (int ai = 0; ai < 2; ++ai)
#pragma unroll
            for (int m = 0; m < 4; ++m) { bf16_t* rowp = O + (size_t)(row0 + ai * HALF + m * 16) * ldc + col0; const float r = rs[ai][m];
#pragma unroll
                for (int bj = 0; bj < 2; ++bj) { f32x4 v0 = acc[ai][bj][m][0] * r, v1 = acc[ai][bj][m][1] * r;
                    if (act) { f32x2 a = gelu_pk((f32x2){v0[0], v0[1]}), b = gelu_pk((f32x2){v0[2], v0[3]}), c = gelu_pk((f32x2){v1[0], v1[1]}), d = gelu_pk((f32x2){v1[2], v1[3]});
                        v0 = (f32x4){a.x, a.y, b.x, b.y}; v1 = (f32x4){c.x, c.y, d.x, d.y}; }
                    u32x4 w; w.x = cvt_pk_bf16(v0[0], v0[1]); w.y = cvt_pk_bf16(v0[2], v0[3]); w.z = cvt_pk_bf16(v1[0], v1[1]); w.w = cvt_pk_bf16(v1[2], v1[3]);
                    *(u32x4*)(rowp + bj * HALF) = w; } }
    }
};
struct EpiPool {
    static constexpr bool PERM = true, PERMA = false, AFTER_DRAIN = false;
    bf16_t* O; int ldc; int col_off; const float* scale;
    __device__ __forceinline__ void operator()(const f32x4 (&acc)[2][2][4][2], const Unit& u, int wr, int wc, int fr, int fq) const {
        const int row0 = u.pm * BM + wr * 64 + fr; const int col0 = u.pn * BM + wc * 32 + 8 * fq;
        f32x4 sv[2][2];
#pragma unroll
        for (int bj = 0; bj < 2; ++bj)
#pragma unroll
            for (int n = 0; n < 2; ++n) sv[bj][n] = scale ? *(const f32x4*)(scale + col0 + bj * HALF + 4 * n) : (f32x4){1.f, 1.f, 1.f, 1.f};
#pragma unroll
        for (int ai = 0; ai < 2; ++ai)
#pragma unroll
            for (int m = 0; m < 4; ++m) { bf16_t* rowp = O + (size_t)(row0 + ai * HALF + m * 16) * ldc + col_off + col0;
#pragma unroll
                for (int bj = 0; bj < 2; ++bj) { const f32x4 v0 = acc[ai][bj][m][0] * sv[bj][0], v1 = acc[ai][bj][m][1] * sv[bj][1];
                    u32x4 w; w.x = cvt_pk_bf16(v0[0], v0[1]); w.y = cvt_pk_bf16(v0[2], v0[3]); w.z = cvt_pk_bf16(v1[0], v1[1]); w.w = cvt_pk_bf16(v1[2], v1[3]);
                    *(u32x4*)(rowp + bj * HALF) = w; } }
    }
};
struct MirrorOrder : StaticOrder {
    __host__ __device__ bool next(int i, Unit& u) const { if (!StaticOrder::next(i, u)) return false; u.pm = nM - 1 - u.pm; return true; }
};
template <bool B16> struct EpiRes {
    static constexpr bool PERM = true, PERMA = false, AFTER_DRAIN = false;
    const float* base; const bf16_t* base16; float* out; bf16_t* xb; float* ss_out;
    __device__ __forceinline__ void operator()(const f32x4 (&acc)[2][2][4][2], const Unit& u, int wr, int wc, int fr, int fq) const {
        const int row0 = u.pm * BM + wr * 64 + fr; const int col0 = u.pn * BM + wc * 32 + 8 * fq;
#pragma unroll
        for (int ai = 0; ai < 2; ++ai) {
            f32x4 pre[4][2][2]; u32x4 p16[4][2];
#pragma unroll
            for (int m = 0; m < 4; ++m) { const size_t off = (size_t)(row0 + ai * HALF + m * 16) * DM + col0;
#pragma unroll
                for (int bj = 0; bj < 2; ++bj) {
                    if constexpr (B16) p16[m][bj] = *(const u32x4*)(base16 + off + bj * HALF);
                    else { pre[m][bj][0] = *(const f32x4*)(base + off + bj * HALF); pre[m][bj][1] = *(const f32x4*)(base + off + bj * HALF + 4); } } }
            asm volatile("" ::: "memory");
#pragma unroll
            for (int m = 0; m < 4; ++m) { const int row = row0 + ai * HALF + m * 16; const size_t off = (size_t)row * DM + col0; float s = 0.f;
#pragma unroll
                for (int bj = 0; bj < 2; ++bj) {
                    f32x4 b0, b1;
                    if constexpr (B16) { const u32x4 p = p16[m][bj]; b0 = (f32x4){bflo(p.x), bfhi(p.x), bflo(p.y), bfhi(p.y)}; b1 = (f32x4){bflo(p.z), bfhi(p.z), bflo(p.w), bfhi(p.w)}; }
                    else { b0 = pre[m][bj][0]; b1 = pre[m][bj][1]; }
                    const f32x4 o0 = b0 + acc[ai][bj][m][0], o1 = b1 + acc[ai][bj][m][1];
                    if (out) { *(f32x4*)(out + off + bj * HALF) = o0; *(f32x4*)(out + off + bj * HALF + 4) = o1; }
                    s += ((o0[0] * o0[0] + o0[1] * o0[1]) + (o0[2] * o0[2] + o0[3] * o0[3])) + ((o1[0] * o1[0] + o1[1] * o1[1]) + (o1[2] * o1[2] + o1[3] * o1[3]));
                    { u32x4 w; w.x = cvt_pk_bf16(o0[0], o0[1]); w.y = cvt_pk_bf16(o0[2], o0[3]); w.z = cvt_pk_bf16(o1[0], o1[1]); w.w = cvt_pk_bf16(o1[2], o1[3]); *(u32x4*)(xb + off + bj * HALF) = w; } }
                s = rows_sum(s);
                if (fq == 0) __hip_atomic_fetch_add(ss_out + row, s, __ATOMIC_RELAXED, __HIP_MEMORY_SCOPE_AGENT);
            }
            asm volatile("" ::: "memory");
        }
    }
};
template <int CTRL> __device__ __forceinline__ float dppz(float src) {
    return __builtin_bit_cast(float, __builtin_amdgcn_update_dpp(0, __builtin_bit_cast(int, src), CTRL, 0xf, 0xf, true));
}
__device__ __forceinline__ f32x2 silu_mul_pk(f32x2 g, f32x2 v) {
    const f32x2 t = g * (-1.4426950408889634f); f32x2 e; e.x = __builtin_amdgcn_exp2f(t.x); e.y = __builtin_amdgcn_exp2f(t.y);
    const f32x2 d = e + 1.0f; f32x2 r; r.x = __builtin_amdgcn_rcpf(d.x); r.y = __builtin_amdgcn_rcpf(d.y);
    return (g * r) * v;
}
__device__ __forceinline__ float silu_f(float x) { return x * __builtin_amdgcn_rcpf(1.0f + __builtin_amdgcn_exp2f(-1.4426950408889634f * x)); }
struct EpiUpConv {
    static constexpr bool PERM = true, PERMA = true, AFTER_DRAIN = false;
    bf16_t* ACT; float* RAW; const float* ss; const float* cw; const float* cb;
    __device__ __forceinline__ void operator()(const f32x4 (&acc)[2][2][4][2], const Unit& u, int wr, int wc, int fr, int fq) const {
        const int rbase = u.pm * BM + wr * 64 + 4 * fr;
        float rs[2][4];
#pragma unroll
        for (int ai = 0; ai < 2; ++ai) { const f32x4 sv = *(const f32x4*)(ss + rbase + ai * HALF);
#pragma unroll
            for (int m = 0; m < 4; ++m) rs[ai][m] = __builtin_amdgcn_rsqf(sv[m] * (1.0f / DM) + EPS); }
        u32x2 keep[2][4];
#pragma unroll
        for (int n = 0; n < 2; ++n) {
            const int ci = wc * 32 + 8 * fq + 4 * n, cgc = u.pn * HALF + ci;
            const f32x4 g0 = *(const f32x4*)(cw + cgc), g1 = *(const f32x4*)(cw + NUP + cgc), g2 = *(const f32x4*)(cw + 2 * NUP + cgc), gb = *(const f32x4*)(cb + cgc);
            const f32x4 v0 = *(const f32x4*)(cw + DFF + cgc), v1 = *(const f32x4*)(cw + NUP + DFF + cgc), v2 = *(const f32x4*)(cw + 2 * NUP + DFF + cgc), vb = *(const f32x4*)(cb + DFF + cgc);
#pragma unroll
            for (int ai = 0; ai < 2; ++ai) {
                float* rawp = RAW + ((size_t)(u.pm * 4 + ai * 2 + wr) * 4) * NUP + u.pn * BM + ci;
                f32x4 G[4], V[4];
#pragma unroll
                for (int m = 0; m < 4; ++m) { G[m] = acc[ai][0][m][n] * rs[ai][m]; V[m] = acc[ai][1][m][n] * rs[ai][m]; }
                f32x4 G3s, G2s, V3s, V2s;
#pragma unroll
                for (int e = 0; e < 4; ++e) { G3s[e] = dppz<0x111>(G[3][e]); G2s[e] = dppz<0x111>(G[2][e]); V3s[e] = dppz<0x111>(V[3][e]); V2s[e] = dppz<0x111>(V[2][e]); }
                f32x4 cg[4], cv[4];
                cg[0] = gb + g0 * G2s + g1 * G3s + g2 * G[0]; cv[0] = vb + v0 * V2s + v1 * V3s + v2 * V[0];
                cg[1] = gb + g0 * G3s + g1 * G[0] + g2 * G[1]; cv[1] = vb + v0 * V3s + v1 * V[0] + v2 * V[1];
                cg[2] = gb + g0 * G[0] + g1 * G[1] + g2 * G[2]; cv[2] = vb + v0 * V[0] + v1 * V[1] + v2 * V[2];
                cg[3] = gb + g0 * G[1] + g1 * G[2] + g2 * G[3]; cv[3] = vb + v0 * V[1] + v1 * V[2] + v2 * V[3];
#pragma unroll
                for (int m = 0; m < 4; ++m) {
                    const f32x2 a01 = silu_mul_pk((f32x2){cg[m][0], cg[m][1]}, (f32x2){cv[m][0], cv[m][1]}), a23 = silu_mul_pk((f32x2){cg[m][2], cg[m][3]}, (f32x2){cv[m][2], cv[m][3]});
                    u32x2 w; w.x = cvt_pk_bf16(a01.x, a01.y); w.y = cvt_pk_bf16(a23.x, a23.y);
                    if (n == 0) keep[ai][m] = w;
                    else if (m >= 2 || fr != 0) { u32x4 o; o.x = keep[ai][m].x; o.y = keep[ai][m].y; o.z = w.x; o.w = w.y;
                        *(u32x4*)(ACT + (size_t)(rbase + ai * HALF + m) * DFF + u.pn * HALF + wc * 32 + 8 * fq) = o; }
                }
                if (fr == 0) { *(f32x4*)(rawp) = G[0]; *(f32x4*)(rawp + HALF) = V[0]; *(f32x4*)(rawp + NUP) = G[1]; *(f32x4*)(rawp + NUP + HALF) = V[1]; }
                if (fr == 15) { *(f32x4*)(rawp + 2 * (size_t)NUP) = G[2]; *(f32x4*)(rawp + 2 * (size_t)NUP + HALF) = V[2]; *(f32x4*)(rawp + 3 * (size_t)NUP) = G[3]; *(f32x4*)(rawp + 3 * (size_t)NUP + HALF) = V[3]; }
            }
        }
    }
};
template <class Epi, class Sched, bool ALIGN_EPI = false, bool SP2 = false>
__device__ __forceinline__ void gemm_phase(LAS unsigned char* lds, const Gemm g, const Sched& S, const Epi& E, int wid) {
    asm volatile("" : "+s"(wid));
    int lane = lane_id(); asm volatile("" : "+v"(lane));
    const int tid = wid * 64 + lane, wr = wid >> 2, wc = wid & 3, fr = lane & 15, fq = lane >> 4;
    const int K = g.K, nt = K / BK;
    unsigned voffA[2], voffB[2];
#pragma unroll
    for (int i = 0; i < 2; ++i) { int R, C; stage_rc(tid * 16 + i * 8192, R, C); const int Rb = Epi::PERM ? ((R & ~31) + perm32(R & 31)) : R;
        const int Ra = Epi::PERMA ? ((R & ~63) + 4 * (R & 15) + ((R >> 4) & 3)) : R;
        voffA[i] = (unsigned)(Ra * g.lda + C) * 2u; voffB[i] = (unsigned)(Rb * g.ldb + C) * 2u; }
    const size_t kstep = (size_t)(BK * 2);
    const size_t hstepA = (size_t)HALF * g.lda * 2, hstepB = (size_t)HALF * g.ldb * 2;
    const size_t tstepA = 2 * hstepA, tstepB = 2 * hstepB;
    const unsigned ldsw = (unsigned)wid * 1024u;
    const int aoff = lds_byte(wr * 64 + fr, fq * 8), boff = lds_byte(wc * 32 + fr, fq * 8);
#define PG8_SA(b, h) (((b) * 2 + (h)) * HTB)
#define PG8_SB(b, h) ((4 + (b) * 2 + (h)) * HTB)
#define PG8_STAGE(bufoff, gbase, voff) do { _Pragma("unroll") for (int _i = 0; _i < 2; ++_i) \
        __builtin_amdgcn_global_load_lds((const unsigned*)((const char*)(gbase) + (voff)[_i]), (LAS unsigned*)(lds + (bufoff) + ldsw + _i * 8192), 16, 0, 0); } while (0)
#define PG8_LDA(dst, b, h) do { _Pragma("unroll") for (int m = 0; m < 4; ++m) _Pragma("unroll") for (int k = 0; k < 2; ++k) dst[m][k] = *(const LAS bf16x8*)(lds + PG8_SA(b, h) + aoff + m * 2048 + k * 1024); } while (0)
#define PG8_LDB(dst, b, h) do { _Pragma("unroll") for (int n = 0; n < 2; ++n) _Pragma("unroll") for (int k = 0; k < 2; ++k) dst[n][k] = *(const LAS bf16x8*)(lds + PG8_SB(b, h) + boff + n * 2048 + k * 1024); } while (0)
#define PG8_MMA(ai, bj, At, Bt) do { __builtin_amdgcn_s_setprio(1); _Pragma("unroll") for (int m = 0; m < 4; ++m) _Pragma("unroll") for (int n = 0; n < 2; ++n) _Pragma("unroll") for (int k = 0; k < 2; ++k) \
        acc[ai][bj][m][n] = __builtin_amdgcn_mfma_f32_16x16x32_bf16(Bt[n][k], At[m][k], acc[ai][bj][m][n], 0, 0, 0); __builtin_amdgcn_s_setprio(0); } while (0)
#define PG8_WAIT_V(n) asm volatile("s_waitcnt vmcnt(" #n ")" ::: "memory")
#define PG8_WAIT_L(n) asm volatile("s_waitcnt lgkmcnt(" #n ")" ::: "memory")
#define PG8_BAR __builtin_amdgcn_s_barrier()
#define PG8_SCHED __builtin_amdgcn_sched_barrier(0)
    Unit cur, nxt; int ui = 0;
    if (!S.next(0, cur)) return;
    f32x4 acc[2][2][4][2];
#pragma unroll
    for (int a = 0; a < 2; ++a)
#pragma unroll
        for (int b = 0; b < 2; ++b)
#pragma unroll
            for (int m = 0; m < 4; ++m)
#pragma unroll
                for (int n = 0; n < 2; ++n) acc[a][b][m][n] = (f32x4){0.f, 0.f, 0.f, 0.f};
    bf16x8 At[4][2], B0[2][2], B1[2][2];
    const char* cA = (const char*)g.A + (size_t)cur.pm * tstepA + (size_t)cur.pn * g.a_pn_off; const char* cB = (const char*)g.Bt + (size_t)cur.pn * tstepB;
    if constexpr (SP2) {
        PG8_STAGE(PG8_SB(0, 0), cB, voffB); PG8_STAGE(PG8_SB(0, 1), cB + hstepB, voffB); PG8_STAGE(PG8_SA(0, 0), cA, voffA); PG8_STAGE(PG8_SA(0, 1), cA + hstepA, voffA);
        if (wr == 1) PG8_BAR;
        PG8_WAIT_V(2); PG8_BAR;
        PG8_STAGE(PG8_SB(1, 0), cB + kstep, voffB); PG8_STAGE(PG8_SA(1, 0), cA + kstep, voffA); PG8_STAGE(PG8_SB(1, 1), cB + hstepB + kstep, voffB);
        PG8_WAIT_V(6); PG8_BAR;
    } else {
        PG8_STAGE(PG8_SB(0, 0), cB, voffB); PG8_STAGE(PG8_SA(0, 0), cA, voffA); PG8_STAGE(PG8_SB(0, 1), cB + hstepB, voffB); PG8_STAGE(PG8_SA(0, 1), cA + hstepA, voffA);
        if (wr == 1) PG8_BAR;
        PG8_WAIT_V(4); PG8_BAR;
        PG8_STAGE(PG8_SB(1, 0), cB + kstep, voffB); PG8_STAGE(PG8_SA(1, 0), cA + kstep, voffA); PG8_STAGE(PG8_SB(1, 1), cB + hstepB + kstep, voffB);
        PG8_WAIT_V(6); PG8_BAR;
    }
    for (;;) {
        const bool has_next = S.next(ui + 1, nxt);
        const char* nA = has_next ? (const char*)g.A + (size_t)nxt.pm * tstepA + (size_t)nxt.pn * g.a_pn_off : cA; const char* nB = has_next ? (const char*)g.Bt + (size_t)nxt.pn * tstepB : cB;
#pragma nounroll
        for (int t = 0; t < nt; t += 2) {
            const bool last = (t == nt - 2);
            const char* a1 = cA + (size_t)(t + 1) * kstep;
            const char* a2 = last ? nA : cA + (size_t)(t + 2) * kstep; const char* b2 = last ? nB : cB + (size_t)(t + 2) * kstep;
            const char* a3 = a2 + kstep; const char* b3 = b2 + kstep;
            if constexpr (SP2) {
            PG8_LDB(B0, 0, 0); PG8_LDB(B1, 0, 1); PG8_SCHED; PG8_LDA(At, 0, 0); PG8_STAGE(PG8_SA(1, 1), a1 + hstepA, voffA);
            PG8_WAIT_V(8); PG8_WAIT_L(0); PG8_BAR; PG8_MMA(0, 0, At, B0); PG8_MMA(0, 1, At, B1); PG8_BAR; PG8_SCHED;
            PG8_LDA(At, 0, 1); PG8_STAGE(PG8_SB(0, 0), b2, voffB); PG8_STAGE(PG8_SB(0, 1), b2 + hstepB, voffB); PG8_STAGE(PG8_SA(0, 0), a2, voffA);
            PG8_WAIT_V(8); PG8_WAIT_L(0); PG8_BAR; PG8_MMA(1, 0, At, B0); PG8_MMA(1, 1, At, B1); PG8_BAR; PG8_SCHED;
            PG8_LDB(B0, 1, 0); PG8_LDB(B1, 1, 1); PG8_SCHED; PG8_LDA(At, 1, 0); PG8_STAGE(PG8_SA(0, 1), a2 + hstepA, voffA);
            PG8_WAIT_V(8); PG8_WAIT_L(0); PG8_BAR; PG8_MMA(0, 0, At, B0); PG8_MMA(0, 1, At, B1); PG8_BAR; PG8_SCHED;
            PG8_LDA(At, 1, 1); PG8_STAGE(PG8_SB(1, 0), b3, voffB); PG8_STAGE(PG8_SB(1, 1), b3 + hstepB, voffB); PG8_STAGE(PG8_SA(1, 0), a3, voffA);
            PG8_WAIT_V(8); PG8_WAIT_L(0); PG8_BAR; PG8_MMA(1, 0, At, B0); PG8_MMA(1, 1, At, B1); PG8_BAR; PG8_SCHED;
            } else {
            PG8_LDB(B0, 0, 0); PG8_SCHED; PG8_LDA(At, 0, 0); PG8_STAGE(PG8_SA(1, 1), a1 + hstepA, voffA);
            PG8_WAIT_L(8); PG8_BAR; PG8_WAIT_L(0); PG8_MMA(0, 0, At, B0); PG8_BAR; PG8_SCHED;
            PG8_LDB(B1, 0, 1); PG8_STAGE(PG8_SB(0, 0), b2, voffB);
            PG8_BAR; PG8_WAIT_L(0); PG8_MMA(0, 1, At, B1); PG8_BAR;
            PG8_LDA(At, 0, 1); PG8_STAGE(PG8_SA(0, 0), a2, voffA);
            PG8_BAR; PG8_WAIT_L(0); PG8_MMA(1, 0, At, B0); PG8_BAR; PG8_SCHED;
            PG8_STAGE(PG8_SB(0, 1), b2 + hstepB, voffB);
            PG8_WAIT_V(6); PG8_BAR; PG8_MMA(1, 1, At, B1); PG8_BAR;
            PG8_LDB(B0, 1, 0); PG8_SCHED; PG8_LDA(At, 1, 0); PG8_STAGE(PG8_SA(0, 1), a2 + hstepA, voffA);
            PG8_WAIT_L(8); PG8_BAR; PG8_WAIT_L(0); PG8_MMA(0, 0, At, B0); PG8_BAR; PG8_SCHED;
            PG8_LDB(B1, 1, 1); PG8_STAGE(PG8_SB(1, 0), b3, voffB);
            PG8_BAR; PG8_WAIT_L(0); PG8_MMA(0, 1, At, B1); PG8_BAR;
            PG8_LDA(At, 1, 1); PG8_STAGE(PG8_SA(1, 0), a3, voffA);
            PG8_BAR; PG8_WAIT_L(0); PG8_MMA(1, 0, At, B0); PG8_BAR; PG8_SCHED;
            PG8_STAGE(PG8_SB(1, 1), b3 + hstepB, voffB);
            PG8_WAIT_V(6); PG8_BAR; PG8_MMA(1, 1, At, B1); PG8_BAR;
            }
        }
        if constexpr (ALIGN_EPI) { if (wr == 0) PG8_BAR; }
        E(acc, cur, wr, wc, fr, fq);
        if (!has_next) break;
#pragma unroll
        for (int a = 0; a < 2; ++a)
#pragma unroll
            for (int b = 0; b < 2; ++b)
#pragma unroll
                for (int m = 0; m < 4; ++m)
#pragma unroll
                    for (int n = 0; n < 2; ++n) acc[a][b][m][n] = (f32x4){0.f, 0.f, 0.f, 0.f};
        cur = nxt; cA = nA; cB = nB; ++ui;
        if constexpr (ALIGN_EPI) { if (wr == 1) PG8_BAR; }
    }
    PG8_WAIT_V(0);
    if constexpr (!ALIGN_EPI) { if (wr == 0) PG8_BAR; }
    PG8_BAR;
#undef PG8_SA
#undef PG8_SB
#undef PG8_STAGE
#undef PG8_LDA
#undef PG8_LDB
#undef PG8_MMA
#undef PG8_WAIT_V
#undef PG8_WAIT_L
#undef PG8_BAR
#undef PG8_SCHED
}
}

namespace fox {
using bf16 = __hip_bfloat16;
constexpr int D = 128;
constexpr float SCALE = 0.08838834764831845f;
constexpr float THR = 8.f;
constexpr int NW = 8, QBLK = 32, KVBLK = 64, QB = NW * QBLK;
constexpr int SHM_V = KVBLK * D * 2, SHM_K = KVBLK * D * 2;
constexpr int OFF_WS = 2 * SHM_V + 2 * SHM_K, OFF_BIAS = OFF_WS + NW * 64 * 4;
constexpr int LDS_BYTES = OFF_BIAS + 2048 * 4;
constexpr int LDQ = QKV_LD, LDO = DM;

#define KSWZ(row, colB) ((row) * 256 + ((colB) ^ (((row) & 7) << 4)))
#define SBAR() __builtin_amdgcn_sched_barrier(0)
__device__ __forceinline__ int v_st(int k, int c) { const int kk = (k & ~0xC) | ((k & 4) << 1) | ((k & 8) >> 1); return ((kk >> 3) * 4 + (c >> 5)) * 512 + ((kk & 7) * 32 + (c & 31)) * 2; }
__device__ __forceinline__ int v_rd_base(int lane) { return ((lane & 3) << 3) | (((lane >> 2) & 3) << 6) | (((lane >> 4) & 1) << 5) | (((lane >> 5) & 1) << 8); }
constexpr int v_rd_off(int d0, int ks, int half) { return d0 * 512 + ks * 4096 + half * 2048; }
__device__ __forceinline__ int crow(int r, int hi) { return (r & 3) + 8 * (r >> 2) + 4 * hi; }
__device__ __forceinline__ unsigned cvtpk(float lo, float hi) { unsigned r; asm volatile("v_cvt_pk_bf16_f32 %0, %1, %2" : "=v"(r) : "v"(lo), "v"(hi)); return r; }
__device__ __forceinline__ bf16x8 load8(const bf16* p) { return *reinterpret_cast<const bf16x8*>(p); }
__device__ __forceinline__ void mask_tile(f32x16& p0, f32x16& p1, int dq, unsigned W) {
    const float NEG = -__builtin_inff();
#pragma unroll
    for (int r = 0; r < 16; ++r) {
        const int c = (r & 3) + 8 * (r >> 2);
        if ((unsigned)(dq - c) >= W) p0[r] = NEG;
        if ((unsigned)(dq - c - 32) >= W) p1[r] = NEG;
    }
}
__device__ __forceinline__ void partialSM(f32x16& p0, f32x16& p1, float& m_reg, float& mn, float& alpha) {
    float pmax = p0[0]; for (int r = 1; r < 16; ++r) pmax = fmaxf(pmax, p0[r]); for (int r = 0; r < 16; ++r) pmax = fmaxf(pmax, p1[r]);
    { auto rr = __builtin_amdgcn_permlane32_swap(__float_as_uint(pmax), __float_as_uint(pmax), false, false);
      pmax = fmaxf(__uint_as_float(rr[0]), __uint_as_float(rr[1])); }
    constexpr float C2 = 1.4426950408889634f * SCALE;
    if (__builtin_expect(__all((pmax - m_reg) * SCALE <= THR), 1)) { mn = m_reg; alpha = 1.f; }
    else { mn = fmaxf(m_reg, pmax); alpha = __builtin_amdgcn_exp2f((m_reg - mn) * C2); m_reg = mn; }
    const float mnL = -mn * C2;
    for (int r = 0; r < 16; ++r) p0[r] = fmaf(p0[r], C2, mnL); for (int r = 0; r < 16; ++r) p1[r] = fmaf(p1[r], C2, mnL);
    for (int r = 0; r < 16; ++r) p0[r] = __builtin_amdgcn_exp2f(p0[r]);
}
__device__ __forceinline__ void finishSM(f32x16& p0, f32x16& p1, float alpha, float& l_reg, bf16x8& pa0, bf16x8& pa1, bf16x8& pa2, bf16x8& pa3) {
    for (int r = 0; r < 16; ++r) p1[r] = __builtin_amdgcn_exp2f(p1[r]);
    float ps = 0; for (int r = 0; r < 16; ++r) ps += p0[r]; for (int r = 0; r < 16; ++r) ps += p1[r];
    { auto rr = __builtin_amdgcn_permlane32_swap(__float_as_uint(ps), __float_as_uint(ps), false, false);
      ps = __uint_as_float(rr[0]) + __uint_as_float(rr[1]); }
    l_reg = l_reg * alpha + ps;
#define PK4(P, B_, OUT) do { unsigned a0 = cvtpk(P[B_+0], P[B_+1]), a1 = cvtpk(P[B_+2], P[B_+3]);                          \
        unsigned b0 = cvtpk(P[B_+4], P[B_+5]), b1 = cvtpk(P[B_+6], P[B_+7]);                                             \
        auto r0 = __builtin_amdgcn_permlane32_swap(a0, b0, false, false); auto r1 = __builtin_amdgcn_permlane32_swap(a1, b1, false, false); \
        u32x4 w = {r0[0], r1[0], r0[1], r1[1]}; OUT = *reinterpret_cast<bf16x8*>(&w); } while (0)
    PK4(p0, 0, pa0); PK4(p0, 8, pa1); PK4(p1, 0, pa2); PK4(p1, 8, pa3);
#undef PK4
}
template <int KB>
__device__ __forceinline__ void qkt(f32x16& p0, f32x16& p1, const char* K_lds, const float* bias_t, int r32, int hi, const bf16x8* qr) {
    const float* bl = bias_t + 4 * hi;
#pragma unroll
    for (int j = 0; j < 4; ++j) { const f32x4 a = *(const f32x4*)(bl + 8 * j), b = *(const f32x4*)(bl + 32 + 8 * j);
#pragma unroll
        for (int e = 0; e < 4; ++e) { p0[4 * j + e] = a[e]; p1[4 * j + e] = b[e]; } }
    const char* kb[4];
#pragma unroll
    for (int dd = 0; dd < 4; ++dd) kb[dd] = K_lds + KB * SHM_K + KSWZ(r32, (dd * 16 + hi * 8) * 2);
#pragma unroll
    for (int d0 = 0; d0 < 8; ++d0) { const char* a = kb[d0 & 3] + (d0 >> 2) * 128;
        bf16x8 b0 = *reinterpret_cast<const bf16x8*>(a);
        bf16x8 b1 = *reinterpret_cast<const bf16x8*>(a + 32 * 256);
        p0 = __builtin_amdgcn_mfma_f32_32x32x16_bf16(b0, qr[d0], p0, 0, 0, 0);
        p1 = __builtin_amdgcn_mfma_f32_32x32x16_bf16(b1, qr[d0], p1, 0, 0, 0); }
}
template <int VB>
__device__ __forceinline__ void pv_tile(f32x16* o, int vb0, bf16x8 pa0, bf16x8 pa1, bf16x8 pa2, bf16x8 pa3) {
#define TRRD(dst, off) asm volatile("ds_read_b64_tr_b16 %0, %1 offset:%2" : "=&v"(dst) : "v"(vb0), "i"(off) : "memory")
#define PV_D0(d0) do { s16x4 l0, l1, l2, l3, h0, h1, h2, h3; constexpr int b_ = VB * SHM_V + v_rd_off(d0, 0, 0); \
        TRRD(l0, b_); TRRD(h0, b_ + 2048); TRRD(l1, b_ + 4096); TRRD(h1, b_ + 6144); TRRD(l2, b_ + 8192); TRRD(h2, b_ + 10240); TRRD(l3, b_ + 12288); TRRD(h3, b_ + 14336); \
        asm volatile("s_waitcnt lgkmcnt(0)" ::: "memory"); SBAR();   \
        o[d0] = __builtin_amdgcn_mfma_f32_32x32x16_bf16(pa0, (bf16x8){l0[0], l0[1], l0[2], l0[3], h0[0], h0[1], h0[2], h0[3]}, o[d0], 0, 0, 0);   \
        o[d0] = __builtin_amdgcn_mfma_f32_32x32x16_bf16(pa1, (bf16x8){l1[0], l1[1], l1[2], l1[3], h1[0], h1[1], h1[2], h1[3]}, o[d0], 0, 0, 0);   \
        o[d0] = __builtin_amdgcn_mfma_f32_32x32x16_bf16(pa2, (bf16x8){l2[0], l2[1], l2[2], l2[3], h2[0], h2[1], h2[2], h2[3]}, o[d0], 0, 0, 0);   \
        o[d0] = __builtin_amdgcn_mfma_f32_32x32x16_bf16(pa3, (bf16x8){l3[0], l3[1], l3[2], l3[3], h3[0], h3[1], h3[2], h3[3]}, o[d0], 0, 0, 0); } while (0)
    PV_D0(0); PV_D0(1); PV_D0(2); PV_D0(3);
#undef PV_D0
#undef TRRD
}
struct BlockRef { const bf16* Q; const bf16* K; const bf16* V; const float* Bias; bf16* O; int P0; };
struct Seam { bf16x8 qr[8]; bf16x8 st_v0, st_v1, st_k0, st_k1; };
#define GROW(p, k0, vo) ((const bf16*)((const char*)((p) + (size_t)(k0) * LDQ) + (vo)))
#define VMW() asm volatile("s_waitcnt vmcnt(0)" ::: "memory")
#define VMWN(n) asm volatile("s_waitcnt vmcnt(%0)" :: "i"(n) : "memory")
#define SLOAD_H(Kp, Vp, Bp, k0) do { S.st_v0 = load8(GROW(Vp, k0, voffk0)); S.st_v1 = load8(GROW(Vp, k0, voffk1));              \
                         S.st_k0 = load8(GROW(Kp, k0, voffk0)); S.st_k1 = load8(GROW(Kp, k0, voffk1)); } while (0)
#define SWRITE_HK(bf) do { *(bf16x8*)(K_lds + (bf) * SHM_K + kws) = S.st_k0; *(bf16x8*)(K_lds + (bf) * SHM_K + kws + 32 * 256) = S.st_k1; } while (0)
#define SWRITE_HV(bf) do { *(bf16x8*)(V_lds + (bf) * SHM_V + vst0) = S.st_v0; *(bf16x8*)(V_lds + (bf) * SHM_V + vst1) = S.st_v1; } while (0)
#define SWRITE_H(bf) do { SWRITE_HV(bf); SWRITE_HK(bf); } while (0)
__device__ __forceinline__ void fox_prime(const BlockRef& cur, char* lds, Seam& S, int wid) {
    asm volatile("" : "+s"(wid));
    int lane = lane_id(); asm volatile("" : "+v"(lane));
    const int tid = wid * 64 + lane, r32 = lane & 31, hi = lane >> 5;
    const int sr = tid >> 4, sc = (tid & 15) * 8, kws = KSWZ(sr, sc * 2); char* K_lds = lds + 2 * SHM_V;
    const unsigned voffk0 = (unsigned)(sr * LDQ + sc) * 2u, voffk1 = voffk0 + 32u * LDQ * 2u, voffq = (unsigned)(r32 * LDQ + hi * 8) * 2u;
    for (int d0 = 0; d0 < 8; ++d0) S.qr[d0] = load8((const bf16*)((const char*)(cur.Q + (size_t)(wid * QBLK) * LDQ) + voffq) + d0 * 16);
    SLOAD_H(cur.K, cur.V, cur.Bias, ((cur.P0 + QB - 1) / KVBLK) * KVBLK); VMW(); SWRITE_HK(0);
    __syncthreads();
}
__device__ __forceinline__ void fox_block(const BlockRef& cur, const BlockRef& nxt, char* lds, Seam& S, int wid) {
    asm volatile("" : "+s"(wid));
    int lane = lane_id(); asm volatile("" : "+v"(lane));
    const int tid = wid * 64 + lane, r32 = lane & 31, hi = lane >> 5;
    constexpr int W = 1 << 30;
    const int NT = (cur.P0 + QB - 1) / KVBLK + 1;
    const int qlo = cur.P0 + wid * QBLK, qm = qlo + r32 - 4 * hi;
    char* V_lds = lds; char* K_lds = lds + 2 * SHM_V; float* bias_lds = (float*)(lds + OFF_BIAS);
    float* ws = (float*)(lds + OFF_WS) + wid * 64; float* li_l = ws, * al_l = ws + 32;
    float m_reg = -1e30f, l_reg = 0; f32x16 o[4] = {};
    const int sr = tid >> 4, sc = (tid & 15) * 8, vst0 = v_st(sr, sc), vst1 = v_st(32 + sr, sc), kws = KSWZ(sr, sc * 2);
    const int vb0 = (int)(uintptr_t)V_lds + v_rd_base(lane);
    const unsigned voffk0 = (unsigned)(sr * LDQ + sc) * 2u, voffk1 = voffk0 + 32u * LDQ * 2u, voffq = (unsigned)(r32 * LDQ + hi * 8) * 2u, voffo = (unsigned)(4 * hi * LDO + r32) * 2u;
    const bf16* Kh = cur.K; const bf16* Vh = cur.V; const float* Bh = cur.Bias;
#define RESC(a) do { if (__any((a) < 1.f)) { if (hi == 0) al_l[r32] = (a); asm volatile("s_waitcnt lgkmcnt(0)" ::: "memory");              \
                     for (int d_ = 0; d_ < 4; ++d_) for (int r = 0; r < 16; ++r) o[d_][r] *= al_l[crow(r, hi)]; } } while (0)
#define KBASE(t) ((NT - 1 - (t)) * KVBLK)
#define MASKT(P0_, P1_, t) do { const int kb_ = KBASE(t); if (kb_ + KVBLK - 1 > qlo) mask_tile(P0_, P1_, qm - kb_, (unsigned)W); } while (0)
    constexpr int NQL = 8;
#define SEAM_K0() do { VMWN(NQL); SWRITE_HK(0); SBAR(); } while (0)
    f32x16 pA0, pA1, pB0, pB1; float mnA, mnB, alA, alB; bf16x8 pa0, pa1, pa2, pa3;
    { if (tid < NT * 16) { const f32x4 bv = *(const f32x4*)(Bh + 4 * tid); *(f32x4*)(bias_lds + 4 * tid) = bv; } __syncthreads(); }
    SWRITE_HV(0); SBAR();
    if (NT > 1) { SLOAD_H(Kh, Vh, Bh, KBASE(1)); }
    SBAR(); qkt<0>(pA0, pA1, K_lds, bias_lds + KBASE(0), r32, hi, S.qr);
    MASKT(pA0, pA1, 0); partialSM(pA0, pA1, m_reg, mnA, alA);
    if (NT > 1) { VMW(); SWRITE_H(1); }
    __syncthreads();
#define HALF_STEP(PX0, PX1, mnX, alX, PY0, PY1, alY, t, KB, VB, SB) do {                                                      \
        SBAR(); qkt<KB>(PX0, PX1, K_lds, bias_lds + KBASE(t), r32, hi, S.qr);                                             \
        finishSM(PY0, PY1, alY, l_reg, pa0, pa1, pa2, pa3); SBAR();                                                           \
        if ((t) + 1 < NT) { SLOAD_H(Kh, Vh, Bh, KBASE((t) + 1)); SBAR(); }                                               \
        pv_tile<VB>(o, vb0, pa0, pa1, pa2, pa3); MASKT(PX0, PX1, (t)); partialSM(PX0, PX1, m_reg, mnX, alX);                                        \
        __syncthreads();                                                                                                      \
        if ((t) + 1 < NT) { VMW(); SWRITE_H(SB); }                                                                          \
        RESC(alX); __syncthreads(); } while (0)
    for (int t = 1; t + 1 < NT; t += 2) {
        HALF_STEP(pB0, pB1, mnB, alB, pA0, pA1, alA, t, 1, 0, 0);
        HALF_STEP(pA0, pA1, mnA, alA, pB0, pB1, alB, t + 1, 0, 1, 1);
    }
    const bool even = (NT & 1) == 0;
    if (even) { SBAR(); qkt<1>(pB0, pB1, K_lds, bias_lds + KBASE(NT - 1), r32, hi, S.qr); SBAR(); }
    SLOAD_H(nxt.K, nxt.V, nxt.Bias, ((nxt.P0 + QB - 1) / KVBLK) * KVBLK); SBAR();
#pragma unroll
    for (int d0 = 0; d0 < 8; ++d0) S.qr[d0] = load8((const bf16*)((const char*)(nxt.Q + (size_t)(wid * QBLK) * LDQ) + voffq) + d0 * 16);
    SBAR();
    finishSM(pA0, pA1, alA, l_reg, pa0, pa1, pa2, pa3); SBAR();
    pv_tile<0>(o, vb0, pa0, pa1, pa2, pa3);
    if (even) { MASKT(pB0, pB1, NT - 1); partialSM(pB0, pB1, m_reg, mnB, alB); __syncthreads(); RESC(alB);
        finishSM(pB0, pB1, alB, l_reg, pa0, pa1, pa2, pa3); SBAR(); pv_tile<1>(o, vb0, pa0, pa1, pa2, pa3); }
    SBAR(); SEAM_K0();
    if (hi == 0) li_l[r32] = l_reg; asm volatile("s_waitcnt lgkmcnt(0)" ::: "memory");
    float rli[16];
#pragma unroll
    for (int r = 0; r < 16; ++r) rli[r] = __builtin_amdgcn_rcpf(li_l[crow(r, hi)]);
    char* Ob = (char*)(cur.O + (size_t)(wid * QBLK) * LDO);
#pragma unroll
    for (int r = 0; r < 16; ++r) { char* Orow = Ob + (size_t)(((r & 3) + 8 * (r >> 2)) * LDO) * 2;
#pragma unroll
        for (int d0 = 0; d0 < 4; ++d0) { const float v = o[d0][r] * rli[r];
            const float vn = __builtin_bit_cast(float, __builtin_amdgcn_mov_dpp(__builtin_bit_cast(int, v), 0xB1, 0xf, 0xf, true));
            if ((r32 & 1) == 0) *(unsigned*)(Orow + voffo + d0 * 64) = cvtpk(v, vn); } }
    __syncthreads();
#undef RESC
#undef KBASE
#undef MASKT
#undef SEAM_K0
#undef HALF_STEP
}
#undef GROW
#undef VMW
#undef VMWN
#undef SLOAD_H
#undef SWRITE_HK
#undef SWRITE_HV
#undef SWRITE_H
#undef SBAR
}

constexpr size_t MiB = 1u << 20;
constexpr size_t WS_WINE = 1 * MiB;
constexpr size_t WS_WOUTE = WS_WINE + 12 * MiB;
constexpr size_t WS_WINO = WS_WOUTE + 8 * MiB;
constexpr size_t WS_WOUTO = WS_WINO + 25 * MiB;
constexpr size_t WS_WUP = WS_WOUTO + 8 * MiB;
constexpr size_t WS_WDOWN = WS_WUP + 88 * MiB;
constexpr size_t WS_WPOOL = WS_WDOWN + 44 * MiB;
constexpr size_t WS_WSP = WS_WPOOL + 512 * 1024;
constexpr size_t WS_SS = WS_WSP + 512 * 1024;
constexpr size_t WS_XB = WS_SS + 1 * MiB;
constexpr size_t WS_SH = WS_XB + 128 * MiB;
constexpr size_t WS_Z = WS_SH;
constexpr size_t WS_MIX = WS_Z + 192 * MiB;
constexpr size_t WS_DP = WS_MIX + 128 * MiB;
constexpr size_t WS_ACT = WS_SH;
constexpr size_t WS_RAW = WS_ACT + 352 * MiB;
constexpr size_t WS_QKV = WS_SH;
constexpr size_t WS_ATT = WS_QKV + 384 * MiB;
constexpr size_t WS_LF = WS_ATT + 128 * MiB;
constexpr size_t WS_CB = WS_LF + 2 * MiB;
constexpr size_t WS_END = WS_CB + 2 * MiB;
static_assert(WS_END <= 1024 * MiB && WS_RAW + 88 * MiB <= WS_END && WS_DP + 64 * MiB <= WS_END, "d_ws map");

#ifndef PHASE_MASK
#define PHASE_MASK 0xffffffffu
#endif
#define PH(n) if constexpr (((PHASE_MASK) >> (n)) & 1u)
constexpr int REP_P0 = 1, REP_P1 = 1, REP_P2 = 1, REP_UP = 1, REP_ATT = 1;
constexpr int NWAVES = 8;
constexpr int LDS_BYTES = 139264;

struct Args { const float* in[19]; float* out; unsigned char* ws; };
#define GAS __attribute__((address_space(1)))
#define CAS __attribute__((address_space(4)))
__device__ __forceinline__ const float* karg_f(int i) {
    const CAS unsigned long long* ka = (const CAS unsigned long long*)__builtin_amdgcn_kernarg_segment_ptr(); asm volatile("" : "+s"(ka));
    return (const float*)(GAS const float*)ka[i];
}
#define IN(i) karg_f(i)

template <int CTRL> __device__ __forceinline__ float dpp_rd(float v) { return __builtin_bit_cast(float, __builtin_amdgcn_mov_dpp(__builtin_bit_cast(int, v), CTRL, 0xf, 0xf, true)); }
__device__ __forceinline__ float wave_sum(float v) {
    v += dpp_rd<0xB1>(v); v += dpp_rd<0x4E>(v); v += dpp_rd<0x141>(v); v += dpp_rd<0x140>(v);
    return rows_sum(v);
}
struct TrItem { const float* W; const float* g; bf16_t* WT; int ldw, nvalid, K, k0, n0src, n0dst; };
__device__ __forceinline__ void tr_load(const TrItem& t, f32x4 (&v)[8], float (&gs)[8], int lane) {
    const int n = t.n0src + 4 * (lane & 7); const bool ok = n < t.nvalid;
#pragma unroll
    for (int i = 0; i < 8; ++i) { const int kk = 8 * i + (lane >> 3);
        v[i] = ok ? *(const f32x4*)(t.W + (size_t)(t.k0 + kk) * t.ldw + n) : (f32x4){0.f, 0.f, 0.f, 0.f};
        gs[i] = t.g ? t.g[t.k0 + kk] : 1.0f; }
}
__device__ __forceinline__ void tr_finish(const TrItem& t, const f32x4 (&v)[8], const float (&gs)[8], LAS float* scr, int lane) {
#pragma unroll
    for (int i = 0; i < 8; ++i) { const int kk = 8 * i + (lane >> 3); LAS float* d = scr + kk * 33 + 4 * (lane & 7);
        d[0] = v[i][0] * gs[i]; d[1] = v[i][1] * gs[i]; d[2] = v[i][2] * gs[i]; d[3] = v[i][3] * gs[i]; }
    asm volatile("s_waitcnt lgkmcnt(0)" ::: "memory");
    const int c = lane & 7;
#pragma unroll
    for (int j = 0; j < 4; ++j) { const int n = (lane >> 3) + 8 * j; const LAS float* s = scr + (8 * c) * 33 + n;
        u32x4 o; o.x = cvt_pk_bf16(s[0 * 33], s[1 * 33]); o.y = cvt_pk_bf16(s[2 * 33], s[3 * 33]); o.z = cvt_pk_bf16(s[4 * 33], s[5 * 33]); o.w = cvt_pk_bf16(s[6 * 33], s[7 * 33]);
        *(u32x4*)(t.WT + (size_t)(t.n0dst + n) * t.K + t.k0 + 8 * c) = o; }
    asm volatile("s_waitcnt lgkmcnt(0)" ::: "memory");
}
#define XB_TMO      128
#define XB_XCNT(j)  (256  + 64 * (j))
#define XB_XSUB(j)  (1280 + 64 * (j))
#define XB_XGEN(j)  (2304 + 64 * (j))
#define XB_TOP      3328
#define XB_TOPGEN   3392
#define XCD_BAR_WORDS 3456
#define XB_SPIN_CAP (1u << 22)
__device__ __forceinline__ unsigned xb_ld(unsigned* p)              { return __hip_atomic_load(p, __ATOMIC_RELAXED, __HIP_MEMORY_SCOPE_AGENT); }
__device__ __forceinline__ unsigned xb_add(unsigned* p, unsigned v) { return __hip_atomic_fetch_add(p, v, __ATOMIC_RELAXED, __HIP_MEMORY_SCOPE_AGENT); }
__device__ __forceinline__ unsigned xb_xcc_id() { return (unsigned)__builtin_amdgcn_s_getreg((3 << 11) | 20) & 0xFu; }
#define XB_SPIN(cond, bar) do { unsigned _sp = 0; while (cond) { __builtin_amdgcn_s_sleep(1); \
    if ((++_sp & 255u) == 0u) { if (xb_ld(&(bar)[XB_TMO])) break; if (_sp > XB_SPIN_CAP) { atomicAdd(&(bar)[XB_TMO], 1u); break; } } } } while (0)
__device__ __forceinline__ void xcd_barrier_complete(unsigned* bar, unsigned x, unsigned& nloc, unsigned& nx) {
    const unsigned G = gridDim.x * gridDim.y * gridDim.z;
    unsigned sum, cnt, mine, sp = 0u;
    for (;;) {
        sum = 0u; cnt = 0u; mine = 0u;
#pragma unroll
        for (unsigned j = 0; j < 16; ++j) { const unsigned c = xb_ld(&bar[XB_XCNT(j)]); sum += c; cnt += (c > 0u) ? 1u : 0u; mine = (j == x) ? c : mine; }
        if (sum == G) break;
        __builtin_amdgcn_s_sleep(1);
        if ((++sp & 255u) == 0u) { if (xb_ld(&bar[XB_TMO])) break; if (sp > XB_SPIN_CAP) { atomicAdd(&bar[XB_TMO], 1u); break; } }
    }
    nloc = mine > 0u ? mine : 1u; nx = cnt > 0u ? cnt : 1u;
}
__device__ __forceinline__ void grid_bar(unsigned* bar, volatile LAS unsigned* st, int wave_s) {
    asm volatile("s_waitcnt vmcnt(0)" ::: "memory");
    __syncthreads();
    if (wave_s == 0) { if (lane_id() == 0) {
        __builtin_amdgcn_s_waitcnt(0);
        const unsigned x = xb_xcc_id();
        unsigned nloc = st[0], nx = st[1];
        if (nloc == 0u) { xcd_barrier_complete(bar, x, nloc, nx); st[0] = nloc; st[1] = nx; }
        const unsigned old = xb_add(&bar[XB_XSUB(x)], 1u);
        const unsigned gen = old / nloc;
        if (old + 1u == (gen + 1u) * nloc) {
            __builtin_amdgcn_fence(__ATOMIC_RELEASE, "agent");
            asm volatile("s_waitcnt vmcnt(0)" ::: "memory");
            const unsigned og = xb_add(&bar[XB_TOP], 1u);
            const unsigned tg = og / nx;
            if (og + 1u == (tg + 1u) * nx) xb_add(&bar[XB_TOPGEN], 1u);
            else XB_SPIN(xb_ld(&bar[XB_TOPGEN]) == tg, bar);
            __builtin_amdgcn_fence(__ATOMIC_ACQUIRE, "agent");
            xb_add(&bar[XB_XGEN(x)], 1u);
            asm volatile("s_waitcnt vmcnt(0)" ::: "memory");
        } else {
            XB_SPIN(xb_ld(&bar[XB_XGEN(x)]) == gen, bar);
            __builtin_amdgcn_fence(__ATOMIC_ACQUIRE, "agent");
            asm volatile("s_waitcnt vmcnt(0)" ::: "memory");
        }
    } }
    __syncthreads();
}
__global__ void __launch_bounds__(NWAVES * 64, 2) mega_fwd(Args args) {
    extern __shared__ __attribute__((aligned(16))) unsigned char lds[];
    cg::grid_group grid = cg::this_grid();
    const int wave_s = __builtin_amdgcn_readfirstlane((int)threadIdx.x >> 6);
#define PHASE_IDS int lane = lane_id(); asm volatile("" : "+v"(lane)); int wave = wave_s; asm volatile("" : "+s"(wave)); const int tid = wave * 64 + lane; (void)tid
    const int G = gridDim.x, bx = blockIdx.x;
    { if (threadIdx.x < 16) ((LAS unsigned*)((LAS unsigned char*)lds + LDS_BYTES - 64))[threadIdx.x] = 0u; __syncthreads();
      if (threadIdx.x == 0) (void)xb_add((unsigned*)karg_f(20) + XB_XCNT(xb_xcc_id()), 1u); }
#define GBAR() grid_bar((unsigned*)karg_f(20), (volatile LAS unsigned*)((LAS unsigned char*)lds + LDS_BYTES - 64), wave_s)
#define WSPTRS unsigned char* ws = (unsigned char*)karg_f(20); const float* x = IN(0); float* R = (float*)karg_f(19); \
    bf16_t* WinE = (bf16_t*)(ws + WS_WINE); bf16_t* WoutE = (bf16_t*)(ws + WS_WOUTE); bf16_t* WinO = (bf16_t*)(ws + WS_WINO); bf16_t* WoutO = (bf16_t*)(ws + WS_WOUTO); \
    bf16_t* Wup = (bf16_t*)(ws + WS_WUP); bf16_t* Wdown = (bf16_t*)(ws + WS_WDOWN); bf16_t* Wpool = (bf16_t*)(ws + WS_WPOOL); bf16_t* Wsp = (bf16_t*)(ws + WS_WSP); \
    float* SS = (float*)(ws + WS_SS); bf16_t* XB = (bf16_t*)(ws + WS_XB); \
    bf16_t* Z = (bf16_t*)(ws + WS_Z); bf16_t* MIX = (bf16_t*)(ws + WS_MIX); bf16_t* DP = (bf16_t*)(ws + WS_DP); \
    bf16_t* ACT = (bf16_t*)(ws + WS_ACT); float* RAW = (float*)(ws + WS_RAW); \
    bf16_t* QKV = (bf16_t*)(ws + WS_QKV); bf16_t* ATT = (bf16_t*)(ws + WS_ATT); float* LF = (float*)(ws + WS_LF); float* CB = (float*)(ws + WS_CB); \
    (void)x; (void)R; (void)WinE; (void)WoutE; (void)WinO; (void)WoutO; (void)Wup; (void)Wdown; (void)Wpool; (void)Wsp; (void)SS; (void)XB; (void)Z; (void)MIX; (void)DP; (void)ACT; (void)RAW; (void)QKV; (void)ATT; (void)LF; (void)CB
    LAS unsigned char* ldsl = (LAS unsigned char*)lds;

    for (int rep_ = 0; rep_ < REP_P0; ++rep_) { if (rep_) GBAR();
    PH(0) {
        PHASE_IDS; WSPTRS;
        LAS float* scr = (LAS float*)(ldsl + wave * 8448);
        const int gw = bx * NWAVES + wave, NGW = G * NWAVES;
        constexpr int I_INE = 32 * 96, I_SQ = 32 * 64, I_POOL = 0, I_INO = 32 * 193, I_UP = 32 * 352, I_DN = 88 * 64;
        constexpr int NITEMS = I_INE + I_SQ + I_POOL + I_INO + I_SQ + 2 * I_UP + 2 * I_DN;
        auto decode = [&](int it) { TrItem t; int r = it;
            if (r < I_INE) { const int kb = r / 96, nb = r % 96; t = TrItem{IN(4), IN(1), WinE, EVEN_IN, EVEN_IN, DM, 64 * kb, 32 * nb, 32 * nb}; return t; } r -= I_INE;
            if (r < I_SQ) { const int kb = r / 64, nb = r % 64; t = TrItem{IN(11), nullptr, WoutE, DM, DM, DM, 64 * kb, 32 * nb, 32 * nb}; return t; } r -= I_SQ;
            if (r < I_POOL) { const int j = r / 32, rr = r % 32, kb = rr / 8, nb = rr % 8; t = TrItem{IN(9) + j * 65536, nullptr, Wpool + j * 65536, 256, 256, 256, 64 * kb, 32 * nb, 32 * nb}; return t; } r -= I_POOL;
            if (r < I_INO) { const int kb = r / 193, nb = r % 193; t = TrItem{IN(12), IN(1) + DM, WinO, ODD_IN, ODD_IN, DM, 64 * kb, 32 * nb, 32 * nb}; return t; } r -= I_INO;
            if (r < I_SQ) { const int kb = r / 64, nb = r % 64; t = TrItem{IN(14), nullptr, WoutO, DM, DM, DM, 64 * kb, 32 * nb, 32 * nb}; return t; } r -= I_SQ;
            if (r < 2 * I_UP) { const int l = r / I_UP, rr = r % I_UP, kb = rr / 352, nb = rr % 352; const int n0 = 32 * nb;
                const int nd = n0 < DFF ? (n0 >> 7) * 256 + (n0 & 127) : ((n0 - DFF) >> 7) * 256 + 128 + ((n0 - DFF) & 127);
                t = TrItem{IN(15) + (size_t)l * DM * NUP, IN(2) + l * DM, Wup + (size_t)l * NUP * DM, NUP, NUP, DM, 64 * kb, n0, nd}; return t; } r -= 2 * I_UP;
            { const int l = r / I_DN, rr = r % I_DN, kb = rr / 64, nb = rr % 64;
                t = TrItem{IN(18) + (size_t)l * DFF * DM, nullptr, Wdown + (size_t)l * DM * DFF, DM, DM, DFF, 64 * kb, 32 * nb, 32 * nb}; return t; } };
        {
            int it = gw; TrItem cur; f32x4 va[8], vb[8]; float ga[8], gb[8];
            if (it < NITEMS) { cur = decode(it); tr_load(cur, va, ga, lane); }
            while (it < NITEMS) {
                const int nit = it + NGW; TrItem nx = cur;
                if (nit < NITEMS) { nx = decode(nit); tr_load(nx, vb, gb, lane); }
                tr_finish(cur, va, ga, scr, lane);
                cur = nx; it = nit;
#pragma unroll
                for (int i = 0; i < 8; ++i) { va[i] = vb[i]; ga[i] = gb[i]; }
            }
        }
        for (int i = bx * 512 + tid; i < 4 * 128 * 128; i += G * 512) { const int t = (i >> 7) & 127, s = i & 127; const float v = ((t >> 6) >= (s >> 6)) ? IN(7)[i] : 0.f; Wsp[i] = (bf16_t)(cvt_pk_bf16(v, 0.f) & 0xffffu); }
        for (int i = bx * 512 + tid; i < 4 * 256 * 256; i += G * 512) { const float v = IN(9)[i] * IN(10)[((i >> 16) << 8) + (i & 255)]; Wpool[i] = (bf16_t)(cvt_pk_bf16(v, 0.f) & 0xffffu); }
        for (int i = bx * 512 + tid; i < 4 * MTOK; i += G * 512) SS[MTOK + i] = 0.f;
        for (int m = gw; m < MTOK; m += 2 * NGW) {
            const int m1 = (m + NGW < MTOK) ? m + NGW : m;
            const f32x4* xr0 = (const f32x4*)(x + (size_t)m * DM) + lane; const f32x4* xr1 = (const f32x4*)(x + (size_t)m1 * DM) + lane; f32x4 v0[8], v1[8]; float s0 = 0.f, s1 = 0.f;
#pragma unroll
            for (int j = 0; j < 8; ++j) { v0[j] = xr0[64 * j]; v1[j] = xr1[64 * j]; }
#pragma unroll
            for (int j = 0; j < 8; ++j) { s0 += (v0[j][0] * v0[j][0] + v0[j][1] * v0[j][1]) + (v0[j][2] * v0[j][2] + v0[j][3] * v0[j][3]); s1 += (v1[j][0] * v1[j][0] + v1[j][1] * v1[j][1]) + (v1[j][2] * v1[j][2] + v1[j][3] * v1[j][3]); }
            s0 = wave_sum(s0); s1 = wave_sum(s1);
            u32x2* o0 = (u32x2*)(XB + (size_t)m * DM) + lane; u32x2* o1 = (u32x2*)(XB + (size_t)m1 * DM) + lane;
#pragma unroll
            for (int j = 0; j < 8; ++j) { u32x2 w; w.x = cvt_pk_bf16(v0[j][0], v0[j][1]); w.y = cvt_pk_bf16(v0[j][2], v0[j][3]); o0[64 * j] = w;
                u32x2 w1; w1.x = cvt_pk_bf16(v1[j][0], v1[j][1]); w1.y = cvt_pk_bf16(v1[j][2], v1[j][3]); o1[64 * j] = w1; }
            if (lane == 0) { SS[m] = s0; SS[m1] = s1; }
        }
    }
    }
    grid.sync();

    for (int rep_ = 0; rep_ < REP_P1; ++rep_) { if (rep_) GBAR();
    PH(1) {
        WSPTRS;
        {
            pg8::Gemm gw_{WoutE + 1024, Wpool, DM, 256, 256, 512}; pg8::StaticOrder Sw; Sw.init(DM, 1024, G, bx);
            pg8::EpiPool Ew{WoutE, DM, 1024, nullptr};
            pg8::gemm_phase<pg8::EpiPool, pg8::StaticOrder, true, true>(ldsl, gw_, Sw, Ew, wave_s);
        }
        pg8::Gemm g{XB, WinE, DM, DM, DM, 0}; pg8::StaticOrder S; S.init(MTOK, EVEN_IN, G, bx);
        pg8::EpiZ<false> E{Z, EVEN_IN, SS, 8, -1, nullptr, nullptr};
        pg8::gemm_phase<pg8::EpiZ<false>, pg8::StaticOrder, true, true>(ldsl, g, S, E, wave_s);
    }
    }
    GBAR();

    for (int rep_ = 0; rep_ < REP_P2; ++rep_) { if (rep_) GBAR();
    PH(2) {
        PHASE_IDS; WSPTRS;
        constexpr int VT_LD = 136, OFF_W = 256 * VT_LD * 2;
        const int fr = lane & 15, fq = lane >> 4;
        for (int unit = bx; unit < 1024; unit += G) {
            const int g = unit & 3, blk = unit >> 2; const int row0 = blk * 128;
            { const int t = tid >> 2, c0 = (tid & 3) * 32;
#pragma unroll
              for (int j = 0; j < 4; ++j) { const u32x4 w = *(const u32x4*)(Wsp + (size_t)g * 16384 + t * 128 + c0 + j * 8); *(LAS u32x4*)(ldsl + OFF_W + (t * VT_LD + c0 + j * 8) * 2) = w; } }
            { const float* lg = IN(5) + g * 256 + 4 * lane; const float* lb = IN(6) + g * 256 + 4 * lane;
              const f32x4 lgv = *(const f32x4*)lg, lbv = *(const f32x4*)lb;
              u32x2 wv[16];
#pragma unroll
              for (int r = 0; r < 16; ++r) wv[r] = *(const u32x2*)(Z + (size_t)(row0 + 16 * wave + r) * EVEN_IN + 1024 + g * 256 + 4 * lane);
#pragma unroll
              for (int pr = 0; pr < 8; ++pr) { const int s = 16 * wave + 2 * pr;
                  const u32x2 w0 = wv[2 * pr], w1 = wv[2 * pr + 1];
                  f32x4 a = (f32x4){bflo(w0.x), bfhi(w0.x), bflo(w0.y), bfhi(w0.y)}, b = (f32x4){bflo(w1.x), bfhi(w1.x), bflo(w1.y), bfhi(w1.y)};
                  const float ma = wave_sum((a[0] + a[1]) + (a[2] + a[3])) * (1.f / 256.f), mb = wave_sum((b[0] + b[1]) + (b[2] + b[3])) * (1.f / 256.f);
                  a = a - ma; b = b - mb;
                  const float va = wave_sum((a[0] * a[0] + a[1] * a[1]) + (a[2] * a[2] + a[3] * a[3])) * (1.f / 256.f), vb = wave_sum((b[0] * b[0] + b[1] * b[1]) + (b[2] * b[2] + b[3] * b[3])) * (1.f / 256.f);
                  const float ra = __builtin_amdgcn_rsqf(va + EPS), rb = __builtin_amdgcn_rsqf(vb + EPS);
                  a = a * ra * lgv + lbv; b = b * rb * lgv + lbv;
#pragma unroll
                  for (int e = 0; e < 4; ++e) *(LAS unsigned*)(ldsl + ((4 * lane + e) * VT_LD + s) * 2) = cvt_pk_bf16(a[e], b[e]);
              } }
            __syncthreads();
            f32x4 acc[8][2];
#pragma unroll
            for (int mt = 0; mt < 8; ++mt) { acc[mt][0] = (f32x4){0.f, 0.f, 0.f, 0.f}; acc[mt][1] = acc[mt][0]; }
#pragma unroll
            for (int ks = 0; ks < 4; ++ks) {
                bf16x8 bfr[2];
#pragma unroll
                for (int nn = 0; nn < 2; ++nn) bfr[nn] = *(const LAS bf16x8*)(ldsl + ((32 * wave + 16 * nn + fr) * VT_LD + 32 * ks + 8 * fq) * 2);
#pragma unroll
                for (int mt = 0; mt < 8; ++mt) { const bf16x8 afr = *(const LAS bf16x8*)(ldsl + OFF_W + ((16 * mt + fr) * VT_LD + 32 * ks + 8 * fq) * 2);
                    acc[mt][0] = __builtin_amdgcn_mfma_f32_16x16x32_bf16(bfr[0], afr, acc[mt][0], 0, 0, 0);
                    acc[mt][1] = __builtin_amdgcn_mfma_f32_16x16x32_bf16(bfr[1], afr, acc[mt][1], 0, 0, 0); }
            }
            u32x2 uwv[8][2]; float biasv[8];
#pragma unroll
            for (int mt = 0; mt < 8; ++mt) { const int t = 16 * mt + fr; biasv[mt] = IN(8)[g * 128 + t];
#pragma unroll
                for (int nn = 0; nn < 2; ++nn) uwv[mt][nn] = *(const u32x2*)(Z + (size_t)(row0 + t) * EVEN_IN + g * 256 + 32 * wave + 16 * nn + 4 * fq); }
            asm volatile("" ::: "memory");
#pragma unroll
            for (int mt = 0; mt < 8; ++mt) { const int t = 16 * mt + fr; const float bias = biasv[mt];
#pragma unroll
                for (int nn = 0; nn < 2; ++nn) { const int d = 32 * wave + 16 * nn + 4 * fq; const size_t row = (size_t)(row0 + t);
                    const u32x2 uw = uwv[mt][nn]; const f32x4 gt = acc[mt][nn] + bias;
                    u32x2 w; w.x = cvt_pk_bf16(bflo(uw.x) * gt[0], bfhi(uw.x) * gt[1]); w.y = cvt_pk_bf16(bflo(uw.y) * gt[2], bfhi(uw.y) * gt[3]);
                    *(u32x2*)(MIX + row * DM + g * 256 + d) = w; } }
            __syncthreads();
        }
        for (int item = bx * 512 + tid; item < 1024 * 128; item += G * 512) {
            const int cc = item & 127, run = item >> 7; const int c0 = cc * 8; const int w = 2 << (c0 >> 8);
            const int rowa = run * 32, pos0 = rowa & (SEQ - 1);
            const bf16_t* P = Z + 2048 + c0; float s[8];
#pragma unroll
            for (int e = 0; e < 8; ++e) s[e] = 0.f;
            for (int j = 1; j <= w; ++j) if (pos0 - j >= 0) { const u32x4 v = *(const u32x4*)(P + (size_t)(rowa - j) * EVEN_IN);
                s[0] += bflo(v.x); s[1] += bfhi(v.x); s[2] += bflo(v.y); s[3] += bfhi(v.y); s[4] += bflo(v.z); s[5] += bfhi(v.z); s[6] += bflo(v.w); s[7] += bfhi(v.w); }
            for (int i0 = 0; i0 < 32; i0 += 8) {
                u32x4 pv[8], qv[8];
#pragma unroll
                for (int j = 0; j < 8; ++j) { const int row = rowa + i0 + j, pos = pos0 + i0 + j;
                    pv[j] = *(const u32x4*)(P + (size_t)row * EVEN_IN);
                    qv[j] = (pos - w >= 0) ? *(const u32x4*)(P + (size_t)(row - w) * EVEN_IN) : (u32x4){0u, 0u, 0u, 0u}; }
#pragma unroll
                for (int j = 0; j < 8; ++j) { const int row = rowa + i0 + j, pos = pos0 + i0 + j;
                    const u32x4 v = pv[j], q = qv[j]; float p[8] = {bflo(v.x), bfhi(v.x), bflo(v.y), bfhi(v.y), bflo(v.z), bfhi(v.z), bflo(v.w), bfhi(v.w)};
                    const float qq[8] = {bflo(q.x), bfhi(q.x), bflo(q.y), bfhi(q.y), bflo(q.z), bfhi(q.z), bflo(q.w), bfhi(q.w)};
#pragma unroll
                    for (int e = 0; e < 8; ++e) s[e] += p[e] - qq[e];
                    const float inv = 1.f / (float)((pos + 1) < w ? (pos + 1) : w);
                    u32x4 o; o.x = cvt_pk_bf16(s[0] * inv - p[0], s[1] * inv - p[1]); o.y = cvt_pk_bf16(s[2] * inv - p[2], s[3] * inv - p[3]);
                    o.z = cvt_pk_bf16(s[4] * inv - p[4], s[5] * inv - p[5]); o.w = cvt_pk_bf16(s[6] * inv - p[6], s[7] * inv - p[7]);
                    *(u32x4*)(MIX + (size_t)row * DM + 1024 + c0) = o; }
            }
        }
    }
    }
    GBAR();

    PH(4) {
        WSPTRS;
        pg8::Gemm g{MIX, WoutE, DM, DM, DM, 0}; pg8::StaticOrder S; S.init(MTOK, DM, G, bx);
        pg8::EpiRes<true> E{nullptr, XB, nullptr, XB, SS + MTOK};
        pg8::gemm_phase<pg8::EpiRes<true>, pg8::StaticOrder, true, true>(ldsl, g, S, E, wave_s);
    }
    GBAR();

#pragma unroll
    for (int layer = 0; layer < 2; ++layer) {
        if (layer == 1) {
            PH(5) {
                WSPTRS;
                pg8::Gemm g{XB, WinO, DM, DM, DM, 0}; pg8::StaticOrder S; S.init(MTOK, QKV_LD, G, bx);
                pg8::EpiZ<false> E{QKV, QKV_LD, SS + 2 * MTOK, 0, -1, nullptr, nullptr};
                pg8::gemm_phase<pg8::EpiZ<false>, pg8::StaticOrder, true, true>(ldsl, g, S, E, wave_s);
                { PHASE_IDS; const int fr = lane & 15, fq = lane >> 4;
                  for (int rb = bx * 128 + wave * 16; rb < MTOK; rb += G * 128) {
                      const bf16_t* ap = XB + (size_t)(rb + fr) * DM + 8 * fq; const bf16_t* bp = WinO + (size_t)(QKV_LD + fr) * DM + 8 * fq;
                      f32x4 acc = (f32x4){0.f, 0.f, 0.f, 0.f};
#pragma unroll 8
                      for (int k = 0; k < DM; k += 32) { const bf16x8 a = *(const bf16x8*)(ap + k), b = *(const bf16x8*)(bp + k);
                          acc = __builtin_amdgcn_mfma_f32_16x16x32_bf16(b, a, acc, 0, 0, 0); }
                      const float rs = __builtin_amdgcn_rsqf((SS + 2 * MTOK)[rb + fr] * (1.0f / DM) + EPS);
                      *(f32x4*)(LF + (size_t)(rb + fr) * 16 + 4 * fq) = acc * rs; } }
            }
            GBAR();
            PH(6) { PHASE_IDS; WSPTRS; if (wave == 0) {
                for (int bh = bx; bh < NB * NHEAD; bh += G) { const int b = bh >> 4, h = bh & 15;
                    const float* src = LF + ((size_t)b * SEQ + 32 * lane) * 16 + h; float v[32]; float run = 0.f; const float bf = IN(13)[h];
#pragma unroll
                    for (int j = 0; j < 32; ++j) { const float xx = src[j * 16] + bf; run += fminf(xx, 0.f) - 0.6931471805599453f * __builtin_amdgcn_logf(1.0f + __builtin_amdgcn_exp2f(-1.4426950408889634f * fabsf(xx))); v[j] = run; }
                    float incl = run;
#pragma unroll
                    for (int o = 1; o < 64; o <<= 1) { const float t = __shfl_up(incl, o); if (lane >= o) incl += t; }
                    const float excl = incl - run; float* dst = CB + (size_t)bh * SEQ + 32 * lane;
#pragma unroll
                    for (int j = 0; j < 32; ++j) dst[j] = -(v[j] + excl) * (1.0f / fox::SCALE);
                }
            } }
            GBAR();
            for (int rep_ = 0; rep_ < REP_ATT; ++rep_) { if (rep_) GBAR();
            PH(7) {
                WSPTRS;
                const int total = NB * NHEAD * 4;
                if (bx < total) {
                    auto mkref = [&](int L, int pass) { const int bh = L >> 2, xq = L & 3; const int qb = pass ? 7 - xq : xq; const int b = bh >> 4, h = bh & 15;
                        fox::BlockRef r; const size_t rowb = (size_t)b * SEQ;
                        r.Q = (const fox::bf16*)QKV + (rowb + qb * 256) * QKV_LD + h * HD; r.K = (const fox::bf16*)QKV + rowb * QKV_LD + DM + h * HD; r.V = (const fox::bf16*)QKV + rowb * QKV_LD + 2 * DM + h * HD;
                        r.Bias = CB + (size_t)bh * SEQ; r.O = (fox::bf16*)ATT + (rowb + qb * 256) * DM + h * HD; r.P0 = qb * 256; return r; };
                    int L = bx, pass = 0; fox::BlockRef cur = mkref(L, 0); fox::Seam S;
                    fox::fox_prime(cur, (char*)lds, S, wave_s);
                    for (;;) {
                        const bool more_pass = pass == 0, more_item = L + G < total, last = !more_pass && !more_item;
                        int Ln = L, passn = pass + 1; if (!more_pass) { passn = 0; Ln = more_item ? L + G : L; }
                        const fox::BlockRef nxt = last ? cur : mkref(Ln, passn);
                        fox::fox_block(cur, nxt, (char*)lds, S, wave_s);
                        if (last) break;
                        cur = nxt; pass = passn; L = Ln;
                    }
                }
            }
            }
            GBAR();
            PH(8) {
                WSPTRS;
                pg8::Gemm g{ATT, WoutO, DM, DM, DM, 0}; pg8::StaticOrder S; S.init(MTOK, DM, G, bx);
                pg8::EpiRes<true> E{nullptr, XB, nullptr, XB, SS + 3 * MTOK};
                pg8::gemm_phase<pg8::EpiRes<true>, pg8::StaticOrder, true, true>(ldsl, g, S, E, wave_s);
            }
            GBAR();
        }
        const float* cw = IN(16) + (size_t)layer * 3 * NUP; const float* cb = IN(17) + (size_t)layer * NUP;
        for (int rep_ = 0; rep_ < REP_UP; ++rep_) { if (rep_) GBAR();
        PH(9) {
            WSPTRS;
            pg8::Gemm g{XB, Wup + (size_t)layer * NUP * DM, DM, DM, DM, 0}; pg8::StaticOrder S; S.init(MTOK, NUP, G, bx);
            pg8::EpiUpConv E{ACT, RAW, SS + (size_t)(layer == 0 ? 1 : 3) * MTOK, cw, cb};
            pg8::gemm_phase<pg8::EpiUpConv, pg8::StaticOrder, true, true>(ldsl, g, S, E, wave_s);
        }
        }
        GBAR();
        PH(10) { PHASE_IDS; WSPTRS; for (int idx = bx * 512 + tid; idx < 512 * (DFF / 4); idx += G * 512) {
            const int sp = idx / (DFF / 4), c = 4 * (idx - sp * (DFF / 4)); const int rc = (c >> 7) * 256 + (c & 127); const bool first = (sp & 31) == 0;
            const float* Rr = RAW + (size_t)sp * 4 * NUP + rc; const float* Rp = Rr - 4 * NUP; const f32x4 z4 = (f32x4){0.f, 0.f, 0.f, 0.f};
            const f32x4 g0 = *(const f32x4*)Rr, g1 = *(const f32x4*)(Rr + NUP), v0 = *(const f32x4*)(Rr + 128), v1 = *(const f32x4*)(Rr + NUP + 128);
            const f32x4 gm1 = first ? z4 : *(const f32x4*)(Rp + 3 * NUP), gm2 = first ? z4 : *(const f32x4*)(Rp + 2 * NUP), vm1 = first ? z4 : *(const f32x4*)(Rp + 3 * NUP + 128), vm2 = first ? z4 : *(const f32x4*)(Rp + 2 * NUP + 128);
            const f32x4 wg0 = *(const f32x4*)(cw + c), wg1 = *(const f32x4*)(cw + NUP + c), wg2 = *(const f32x4*)(cw + 2 * NUP + c), bg = *(const f32x4*)(cb + c);
            const f32x4 wv0 = *(const f32x4*)(cw + DFF + c), wv1 = *(const f32x4*)(cw + NUP + DFF + c), wv2 = *(const f32x4*)(cw + 2 * NUP + DFF + c), bv = *(const f32x4*)(cb + DFF + c);
            const f32x4 cg0 = bg + wg0 * gm2 + wg1 * gm1 + wg2 * g0, cv0 = bv + wv0 * vm2 + wv1 * vm1 + wv2 * v0;
            const f32x4 cg1 = bg + wg0 * gm1 + wg1 * g0 + wg2 * g1, cv1 = bv + wv0 * vm1 + wv1 * v0 + wv2 * v1;
            u32x2 o0, o1;
            o0.x = cvt_pk_bf16(pg8::silu_f(cg0[0]) * cv0[0], pg8::silu_f(cg0[1]) * cv0[1]); o0.y = cvt_pk_bf16(pg8::silu_f(cg0[2]) * cv0[2], pg8::silu_f(cg0[3]) * cv0[3]);
            o1.x = cvt_pk_bf16(pg8::silu_f(cg1[0]) * cv1[0], pg8::silu_f(cg1[1]) * cv1[1]); o1.y = cvt_pk_bf16(pg8::silu_f(cg1[2]) * cv1[2], pg8::silu_f(cg1[3]) * cv1[3]);
            *(u32x2*)(ACT + (size_t)(sp * 64) * DFF + c) = o0; *(u32x2*)(ACT + (size_t)(sp * 64 + 1) * DFF + c) = o1;
        } }
        GBAR();
        PH(11) {
            WSPTRS;
            pg8::Gemm g{ACT, Wdown + (size_t)layer * DM * DFF, DFF, DFF, DFF, 0}; pg8::MirrorOrder S; S.init(MTOK, DM, G, bx);
            pg8::EpiRes<true> E{nullptr, XB, nullptr, XB, SS + (size_t)(layer == 0 ? 2 : 4) * MTOK};
            pg8::gemm_phase<pg8::EpiRes<true>, pg8::MirrorOrder, true, true>(ldsl, g, S, E, wave_s);
        }
        GBAR();
    }
    PH(12) {
        PHASE_IDS; WSPTRS;
        const float* ss4 = SS + 4 * (size_t)MTOK; const float* gf = IN(3);
        const int c4 = tid; const f32x4 gv = ((const f32x4*)gf)[c4];
        for (int rb = bx * 16; rb < MTOK; rb += G * 16) {
            u32x2 v[16]; float rs[16];
#pragma unroll
            for (int j = 0; j < 16; ++j) { v[j] = ((const u32x2*)XB)[(size_t)(rb + j) * 512 + c4]; rs[j] = ss4[rb + j]; }
#pragma unroll
            for (int j = 0; j < 16; ++j) { const float r = __builtin_amdgcn_rsqf(rs[j] * (1.0f / DM) + EPS); const f32x4 xv = (f32x4){bflo(v[j].x), bfhi(v[j].x), bflo(v[j].y), bfhi(v[j].y)};
                ((f32x4*)R)[(size_t)(rb + j) * 512 + c4] = xv * r * gv; }
        }
    }
}

extern "C" void kernel_launch(void* const* d_in, const int* in_sizes, int n_in, void* d_out, int out_size, void* d_ws, size_t ws_size, hipStream_t stream) {
    static int grid = 0;
    if (grid == 0) {
        if (n_in != 19 || out_size != MTOK * DM || ws_size < WS_END) { fprintf(stderr, "kernel_launch: unexpected shapes (n_in %d out %d ws %zu)\n", n_in, out_size, ws_size); grid = -1; return; }
        int dev = 0, cus = 0, per_cu = 0;
        (void)hipGetDevice(&dev); (void)hipDeviceGetAttribute(&cus, hipDeviceAttributeMultiprocessorCount, dev);
        if (hipFuncSetAttribute((const void*)mega_fwd, hipFuncAttributeMaxDynamicSharedMemorySize, LDS_BYTES) != hipSuccess) { fprintf(stderr, "kernel_launch: hipFuncSetAttribute failed\n"); grid = -1; return; }
        if (hipOccupancyMaxActiveBlocksPerMultiprocessor(&per_cu, (const void*)mega_fwd, NWAVES * 64, LDS_BYTES) != hipSuccess || per_cu < 1) { fprintf(stderr, "kernel_launch: occupancy query gave %d\n", per_cu); per_cu = 1; }
        (void)hipGetLastError();
        grid = cus * 1;
    }
    if (grid < 0) return;
    if (hipMemsetAsync(d_ws, 0, 16384, stream) != hipSuccess) { fprintf(stderr, "kernel_launch: memset failed\n"); return; }
    Args a{};
    for (int i = 0; i < 19; ++i) a.in[i] = (const float*)d_in[i];
    a.out = (float*)d_out; a.ws = (unsigned char*)d_ws;
    void* params[] = {&a};
    hipError_t e = hipLaunchCooperativeKernel((const void*)mega_fwd, dim3(grid), dim3(NWAVES * 64), params, LDS_BYTES, stream);
    if (e != hipSuccess) fprintf(stderr, "kernel_launch: cooperative launch failed: %s (grid %d)\n", hipGetErrorString(e), grid);
}
```

```cpp
#include <hip/hip_runtime.h>
#include <hip/hip_bf16.h>
#include <hip/hip_cooperative_groups.h>
#include <cstdio>
#include <cstdint>
namespace cg = cooperative_groups;

#define LAS __attribute__((address_space(3)))
typedef unsigned short bf16_t;
typedef short bf16x8 __attribute__((ext_vector_type(8)));
typedef short s16x4 __attribute__((ext_vector_type(4)));
typedef float f32x4 __attribute__((ext_vector_type(4)));
typedef float f32x2 __attribute__((ext_vector_type(2)));
typedef float f32x16 __attribute__((ext_vector_type(16)));
typedef unsigned u32x4 __attribute__((ext_vector_type(4)));
typedef unsigned u32x2 __attribute__((ext_vector_type(2)));

constexpr int DM = 2048, NB = 16, SEQ = 2048, MTOK = NB * SEQ;
constexpr int DFF = 5632, NUP = 2 * DFF;
constexpr int EVEN_IN = 3072, ODD_IN = 6160, ODD_PAD = 6400, QKV_LD = 6144;
constexpr int NHEAD = 16, HD = 128;
constexpr float EPS = 1e-6f;

__device__ __forceinline__ unsigned cvt_pk_bf16(float lo, float hi) { unsigned r; asm volatile("v_cvt_pk_bf16_f32 %0, %1, %2" : "=v"(r) : "v"(lo), "v"(hi)); return r; }
__device__ __forceinline__ float bf2f(unsigned short h) { return __uint_as_float(((unsigned)h) << 16); }
__device__ __forceinline__ float bflo(unsigned w) { return __uint_as_float(w << 16); }
__device__ __forceinline__ float bfhi(unsigned w) { return __uint_as_float(w & 0xffff0000u); }

__device__ __forceinline__ int lane_id() { int l; asm volatile("v_mbcnt_lo_u32_b32 %0, -1, 0\n\tv_mbcnt_hi_u32_b32 %0, -1, %0" : "=v"(l)); return l; }
__device__ __forceinline__ float rows_sum(float v) {
    { auto r = __builtin_amdgcn_permlane16_swap(__float_as_uint(v), __float_as_uint(v), false, false); v = __uint_as_float(r[0]) + __uint_as_float(r[1]); }
    { auto r = __builtin_amdgcn_permlane32_swap(__float_as_uint(v), __float_as_uint(v), false, false); v = __uint_as_float(r[0]) + __uint_as_float(r[1]); }
    return v;
}
namespace pg8 {
constexpr int BM = 256, BK = 64, HALF = 128, HTB = HALF * BK * 2, STAGE_BYTES = 8 * HTB, NXCD = 8, WGM = 8;
__host__ __device__ __forceinline__ int lds_byte(int r, int c) { const int st = (r >> 4) * 2 + (c >> 5), rr = r & 15, cc = c & 31, ob = rr * 64 + cc * 2; return st * 1024 + (ob ^ (((ob >> 9) & 1) << 5)); }
__host__ __device__ __forceinline__ void stage_rc(int b, int& R, int& C) { const int st = b / 1024, sb = b % 1024, swz = sb ^ (((sb >> 9) & 1) << 5); R = (st >> 1) * 16 + swz / 64; C = (st & 1) * 32 + (swz % 64) / 2; }
__host__ __device__ __forceinline__ int perm32(int rho) { const int n = rho >> 4, i = rho & 15; return 8 * (i >> 2) + 4 * n + (i & 3); }

struct Unit { int pm, pn; };
struct Gemm { const bf16_t* A; const bf16_t* Bt; int lda, ldb, K; int a_pn_off; };

struct StaticOrder {
    int nM, nN, nwg, G, c;
    __host__ __device__ void init(int M, int N, int G_, int c_) { nM = M / BM; nN = N / BM; nwg = nM * nN; G = G_; c = c_; }
    __host__ __device__ bool next(int i, Unit& u) const {
        const long L = (long)i * G + c; if (L >= nwg) return false;
        int wgid = (int)L; { const int q = nwg / NXCD, r = nwg % NXCD, xcd = wgid % NXCD, off = wgid / NXCD; wgid = (xcd < r ? xcd * (q + 1) : r * (q + 1) + (xcd - r) * q) + off; }
        const int nig = WGM * nN, gid = wgid / nig, fm = gid * WGM, gsz = (nM - fm) < WGM ? (nM - fm) : WGM;
        u.pm = fm + ((wgid % nig) % gsz); u.pn = (wgid % nig) / gsz; return true;
    }
};

__device__ __forceinline__ f32x2 gelu_pk(f32x2 v) {
    const f32x2 av = __builtin_elementwise_abs(v), d = av * 0.2316418882f + 1.0f;
    f32x2 t; t.x = __builtin_amdgcn_rcpf(d.x); t.y = __builtin_amdgcn_rcpf(d.y);
    f32x2 q = t * 0.5307027145f + (-0.7265760135f); q = q * t + 0.7107068705f; q = q * t + (-0.142248368f); q = q * t + 0.127414796f; q = q * t;
    const f32x2 s = (v * v) * (-0.72134752044f);
    f32x2 e; e.x = __builtin_amdgcn_exp2f(s.x); e.y = __builtin_amdgcn_exp2f(s.y);
    const f32x2 m = v * (q * e), r = v - m;
    f32x2 o; o.x = v.x < 0.f ? m.x : r.x; o.y = v.y < 0.f ? m.y : r.y; return o;
}

__device__ __forceinline__ void load_rstd(float (&rs)[2][4], const float* ss, int rowbase) {
#pragma unroll
    for (int ai = 0; ai < 2; ++ai)
#pragma unroll
        for (int m = 0; m < 4; ++m) rs[ai][m] = __builtin_amdgcn_rsqf(ss[rowbase + ai * HALF + m * 16] * (1.0f / DM) + EPS);
}

template <bool HAS_LF> struct EpiZ {
    static constexpr bool PERM = true, PERMA = false, AFTER_DRAIN = false;
    bf16_t* O; int ldc; const float* ss; int gelu_tiles; int lf_tile; const float* bfg; float* LF;
    __device__ __forceinline__ void operator()(const f32x4 (&acc)[2][2][4][2], const Unit& u, int wr, int wc, int fr, int fq) const {
        const int row0 = u.pm * BM + wr * 64 + fr;
        float rs[2][4]; load_rstd(rs, ss, row0);
        if (HAS_LF && u.pn == lf_tile) {
            if (wc == 0 && fq < 2) {
#pragma unroll
                for (int ai = 0; ai < 2; ++ai)
#pragma unroll
                    for (int m = 0; m < 4; ++m) { const int row = row0 + ai * HALF + m * 16;
#pragma unroll
                        for (int n = 0; n < 2; ++n) { const f32x4 v = acc[ai][0][m][n] * rs[ai][m]; const int col = 8 * fq + 4 * n; f32x4 o;
#pragma unroll
                            for (int e = 0; e < 4; ++e) o[e] = v[e];
                            *(f32x4*)(LF + (size_t)row * 16 + col) = o; } }
            }
            return;
        }
        const int col0 = u.pn * BM + wc * 32 + 8 * fq; const bool act = u.pn < gelu_tiles;
#pragma unroll
        for (int ai = 0; ai < 2; ++ai)
#pragma unroll
            for (int m = 0; m < 4; ++m) { bf16_t* rowp = O + (size_t)(row0 + ai * HALF + m * 16) * ldc + col0; const float r = rs[ai][m];
#pragma unroll
                for (int bj = 0; bj < 2; ++bj) { f32x4 v0 = acc[ai][bj][m][0] * r, v1 = acc[ai][bj][m][1] * r;
                    if (act) { f32x2 a = gelu_pk((f32x2){v0[0], v0[1]}), b = gelu_pk((f32x2){v0[2], v0[3]}), c = gelu_pk((f32x2){v1[0], v1[1]}), d = gelu_pk((f32x2){v1[2], v1[3]});
                        v0 = (f32x4){a.x, a.y, b.x, b.y}; v1 = (f32x4){c.x, c.y, d.x, d.y}; }
                    u32x4 w; w.x = cvt_pk_bf16(v0[0], v0[1]); w.y = cvt_pk_bf16(v0[2], v0[3]); w.z = cvt_pk_bf16(v1[0], v1[1]); w.w = cvt_pk_bf16(v1[2], v1[3]);
                    *(u32x4*)(rowp + bj * HALF) = w; } }
    }
};
struct EpiPool {
    static constexpr bool PERM = true, PERMA = false, AFTER_DRAIN = false;
    bf16_t* O; int ldc; int col_off; const float* scale;
    __device__ __forceinline__ void operator()(const f32x4 (&acc)[2][2][4][2], const Unit& u, int wr, int wc, int fr, int fq) const {
        const int row0 = u.pm * BM + wr * 64 + fr; const int col0 = u.pn * BM + wc * 32 + 8 * fq;
        f32x4 sv[2][2];
#pragma unroll
        for (int bj = 0; bj < 2; ++bj)
#pragma unroll
            for (int n = 0; n < 2; ++n) sv[bj][n] = scale ? *(const f32x4*)(scale + col0 + bj * HALF + 4 * n) : (f32x4){1.f, 1.f, 1.f, 1.f};
#pragma unroll
        for (int ai = 0; ai < 2; ++ai)
#pragma unroll
            for (int m = 0; m < 4; ++m) { bf16_t* rowp = O + (size_t)(row0 + ai * HALF + m * 16) * ldc + col_off + col0;
#pragma unroll
                for (int bj = 0; bj < 2; ++bj) { const f32x4 v0 = acc[ai][bj][m][0] * sv[bj][0], v1 = acc[ai][bj][m][1] * sv[bj][1];
                    u32x4 w; w.x = cvt_pk_bf16(v0[0], v0[1]); w.y = cvt_pk_bf16(v0[2], v0[3]); w.z = cvt_pk_bf16(v1[0], v1[1]); w.w = cvt_pk_bf16(v1[2], v1[3]);
                    *(u32x4*)(rowp + bj * HALF) = w; } }
    }
};
struct MirrorOrder : StaticOrder {
    __host__ __device__ bool next(int i, Unit& u) const { if (!StaticOrder::next(i, u)) return false; u.pm = nM - 1 - u.pm; return true; }
};
template <bool B16> struct EpiRes {
    static constexpr bool PERM = true, PERMA = false, AFTER_DRAIN = false;
    const float* base; const bf16_t* base16; float* out; bf16_t* xb; float* ss_out;
    __device__ __forceinline__ void operator()(const f32x4 (&acc)[2][2][4][2], const Unit& u, int wr, int wc, int fr, int fq) const {
        const int row0 = u.pm * BM + wr * 64 + fr; const int col0 = u.pn * BM + wc * 32 + 8 * fq;
#pragma unroll
        for (int ai = 0; ai < 2; ++ai) {
            f32x4 pre[4][2][2]; u32x4 p16[4][2];
#pragma unroll
            for (int m = 0; m < 4; ++m) { const size_t off = (size_t)(row0 + ai * HALF + m * 16) * DM + col0;
#pragma unroll
                for (int bj = 0; bj < 2; ++bj) {
                    if constexpr (B16) p16[m][bj] = *(const u32x4*)(base16 + off + bj * HALF);
                    else { pre[m][bj][0] = *(const f32x4*)(base + off + bj * HALF); pre[m][bj][1] = *(const f32x4*)(base + off + bj * HALF + 4); } } }
            asm volatile("" ::: "memory");
#pragma unroll
            for (int m = 0; m < 4; ++m) { const int row = row0 + ai * HALF + m * 16; const size_t off = (size_t)row * DM + col0; float s = 0.f;
#pragma unroll
                for (int bj = 0; bj < 2; ++bj) {
                    f32x4 b0, b1;
                    if constexpr (B16) { const u32x4 p = p16[m][bj]; b0 = (f32x4){bflo(p.x), bfhi(p.x), bflo(p.y), bfhi(p.y)}; b1 = (f32x4){bflo(p.z), bfhi(p.z), bflo(p.w), bfhi(p.w)}; }
                    else { b0 = pre[m][bj][0]; b1 = pre[m][bj][1]; }
                    const f32x4 o0 = b0 + acc[ai][bj][m][0], o1 = b1 + acc[ai][bj][m][1];
                    if (out) { *(f32x4*)(out + off + bj * HALF) = o0; *(f32x4*)(out + off + bj * HALF + 4) = o1; }
                    s += ((o0[0] * o0[0] + o0[1] * o0[1]) + (o0[2] * o0[2] + o0[3] * o0[3])) + ((o1[0] * o1[0] + o1[1] * o1[1]) + (o1[2] * o1[2] + o1[3] * o1[3]));
                    { u32x4 w; w.x = cvt_pk_bf16(o0[0], o0[1]); w.y = cvt_pk_bf16(o0[2], o0[3]); w.z = cvt_pk_bf16(o1[0], o1[1]); w.w = cvt_pk_bf16(o1[2], o1[3]); *(u32x4*)(xb + off + bj * HALF) = w; } }
                s = rows_sum(s);
                if (fq == 0) __hip_atomic_fetch_add(ss_out + row, s, __ATOMIC_RELAXED, __HIP_MEMORY_SCOPE_AGENT);
            }
            asm volatile("" ::: "memory");
        }
    }
};
template <int CTRL> __device__ __forceinline__ float dppz(float src) {
    return __builtin_bit_cast(float, __builtin_amdgcn_update_dpp(0, __builtin_bit_cast(int, src), CTRL, 0xf, 0xf, true));
}
__device__ __forceinline__ f32x2 silu_mul_pk(f32x2 g, f32x2 v) {
    const f32x2 t = g * (-1.4426950408889634f); f32x2 e; e.x = __builtin_amdgcn_exp2f(t.x); e.y = __builtin_amdgcn_exp2f(t.y);
    const f32x2 d = e + 1.0f; f32x2 r; r.x = __builtin_amdgcn_rcpf(d.x); r.y = __builtin_amdgcn_rcpf(d.y);
    return (g * r) * v;
}
__device__ __forceinline__ float silu_f(float x) { return x * __builtin_amdgcn_rcpf(1.0f + __builtin_amdgcn_exp2f(-1.4426950408889634f * x)); }
struct EpiUpConv {
    static constexpr bool PERM = true, PERMA = true, AFTER_DRAIN = false;
    bf16_t* ACT; float* RAW; const float* ss; const float* cw; const float* cb;
    __device__ __forceinline__ void operator()(const f32x4 (&acc)[2][2][4][2], const Unit& u, int wr, int wc, int fr, int fq) const {
        const int rbase = u.pm * BM + wr * 64 + 4 * fr;
        float rs[2][4];
#pragma unroll
        for (int ai = 0; ai < 2; ++ai) { const f32x4 sv = *(const f32x4*)(ss + rbase + ai * HALF);
#pragma unroll
            for (int m = 0; m < 4; ++m) rs[ai][m] = __builtin_amdgcn_rsqf(sv[m] * (1.0f / DM) + EPS); }
        u32x2 keep[2][4];
#pragma unroll
        for (int n = 0; n < 2; ++n) {
            const int ci = wc * 32 + 8 * fq + 4 * n, cgc = u.pn * HALF + ci;
            const f32x4 g0 = *(const f32x4*)(cw + cgc), g1 = *(const f32x4*)(cw + NUP + cgc), g2 = *(const f32x4*)(cw + 2 * NUP + cgc), gb = *(const f32x4*)(cb + cgc);
            const f32x4 v0 = *(const f32x4*)(cw + DFF + cgc), v1 = *(const f32x4*)(cw + NUP + DFF + cgc), v2 = *(const f32x4*)(cw + 2 * NUP + DFF + cgc), vb = *(const f32x4*)(cb + DFF + cgc);
#pragma unroll
            for (int ai = 0; ai < 2; ++ai) {
                float* rawp = RAW + ((size_t)(u.pm * 4 + ai * 2 + wr) * 4) * NUP + u.pn * BM + ci;
                f32x4 G[4], V[4];
#pragma unroll
                for (int m = 0; m < 4; ++m) { G[m] = acc[ai][0][m][n] * rs[ai][m]; V[m] = acc[ai][1][m][n] * rs[ai][m]; }
                f32x4 G3s, G2s, V3s, V2s;
#pragma unroll
                for (int e = 0; e < 4; ++e) { G3s[e] = dppz<0x111>(G[3][e]); G2s[e] = dppz<0x111>(G[2][e]); V3s[e] = dppz<0x111>(V[3][e]); V2s[e] = dppz<0x111>(V[2][e]); }
                f32x4 cg[4], cv[4];
                cg[0] = gb + g0 * G2s + g1 * G3s + g2 * G[0]; cv[0] = vb + v0 * V2s + v1 * V3s + v2 * V[0];
                cg[1] = gb + g0 * G3s + g1 * G[0] + g2 * G[1]; cv[1] = vb + v0 * V3s + v1 * V[0] + v2 * V[1];
                cg[2] = gb + g0 * G[0] + g1 * G[1] + g2 * G[2]; cv[2] = vb + v0 * V[0] + v1 * V[1] + v2 * V[2];
                cg[3] = gb + g0 * G[1] + g1 * G[2] + g2 * G[3]; cv[3] = vb + v0 * V[1] + v1 * V[2] + v2 * V[3];
#pragma unroll
                for (int m = 0; m < 4; ++m) {
                    const f32x2 a01 = silu_mul_pk((f32x2){cg[m][0], cg[m][1]}, (f32x2){cv[m][0], cv[m][1]}), a23 = silu_mul_pk((f32x2){cg[m][2], cg[m][3]}, (f32x2){cv[m][2], cv[m][3]});
                    u32x2 w; w.x = cvt_pk_bf16(a01.x, a01.y); w.y = cvt_pk_bf16(a23.x, a23.y);
                    if (n == 0) keep[ai][m] = w;
                    else if (m >= 2 || fr != 0) { u32x4 o; o.x = keep[ai][m].x; o.y = keep[ai][m].y; o.z = w.x; o.w = w.y;
                        *(u32x4*)(ACT + (size_t)(rbase + ai * HALF + m) * DFF + u.pn * HALF + wc * 32 + 8 * fq) = o; }
                }
                if (fr == 0) { *(f32x4*)(rawp) = G[0]; *(f32x4*)(rawp + HALF) = V[0]; *(f32x4*)(rawp + NUP) = G[1]; *(f32x4*)(rawp + NUP + HALF) = V[1]; }
                if (fr == 15) { *(f32x4*)(rawp + 2 * (size_t)NUP) = G[2]; *(f32x4*)(rawp + 2 * (size_t)NUP + HALF) = V[2]; *(f32x4*)(rawp + 3 * (size_t)NUP) = G[3]; *(f32x4*)(rawp + 3 * (size_t)NUP + HALF) = V[3]; }
            }
        }
    }
};
template <class Epi, class Sched, bool ALIGN_EPI = false, bool SP2 = false>
__device__ __forceinline__ void gemm_phase(LAS unsigned char* lds, const Gemm g, const Sched& S, const Epi& E, int wid) {
    asm volatile("" : "+s"(wid));
    int lane = lane_id(); asm volatile("" : "+v"(lane));
    const int tid = wid * 64 + lane, wr = wid >> 2, wc = wid & 3, fr = lane & 15, fq = lane >> 4;
    const int K = g.K, nt = K / BK;
    unsigned voffA[2], voffB[2];
#pragma unroll
    for (int i = 0; i < 2; ++i) { int R, C; stage_rc(tid * 16 + i * 8192, R, C); const int Rb = Epi::PERM ? ((R & ~31) + perm32(R & 31)) : R;
        const int Ra = Epi::PERMA ? ((R & ~63) + 4 * (R & 15) + ((R >> 4) & 3)) : R;
        voffA[i] = (unsigned)(Ra * g.lda + C) * 2u; voffB[i] = (unsigned)(Rb * g.ldb + C) * 2u; }
    const size_t kstep = (size_t)(BK * 2);
    const size_t hstepA = (size_t)HALF * g.lda * 2, hstepB = (size_t)HALF * g.ldb * 2;
    const size_t tstepA = 2 * hstepA, tstepB = 2 * hstepB;
    const unsigned ldsw = (unsigned)wid * 1024u;
    const int aoff = lds_byte(wr * 64 + fr, fq * 8), boff = lds_byte(wc * 32 + fr, fq * 8);
#define PG8_SA(b, h) (((b) * 2 + (h)) * HTB)
#define PG8_SB(b, h) ((4 + (b) * 2 + (h)) * HTB)
#define PG8_STAGE(bufoff, gbase, voff) do { _Pragma("unroll") for (int _i = 0; _i < 2; ++_i) \
        __builtin_amdgcn_global_load_lds((const unsigned*)((const char*)(gbase) + (voff)[_i]), (LAS unsigned*)(lds + (bufoff) + ldsw + _i * 8192), 16, 0, 0); } while (0)
#define PG8_LDA(dst, b, h) do { _Pragma("unroll") for (int m = 0; m < 4; ++m) _Pragma("unroll") for (int k = 0; k < 2; ++k) dst[m][k] = *(const LAS bf16x8*)(lds + PG8_SA(b, h) + aoff + m * 2048 + k * 1024); } while (0)
#define PG8_LDB(dst, b, h) do { _Pragma("unroll") for (int n = 0; n < 2; ++n) _Pragma("unroll") for (int k = 0; k < 2; ++k) dst[n][k] = *(const LAS bf16x8*)(lds + PG8_SB(b, h) + boff + n * 2048 + k * 1024); } while (0)
#define PG8_MMA(ai, bj, At, Bt) do { __builtin_amdgcn_s_setprio(1); _Pragma("unroll") for (int m = 0; m < 4; ++m) _Pragma("unroll") for (int n = 0; n < 2; ++n) _Pragma("unroll") for (int k = 0; k < 2; ++k) \
        acc[ai][bj][m][n] = __builtin_amdgcn_mfma_f32_16x16x32_bf16(Bt[n][k], At[m][k], acc[ai][bj][m][n], 0, 0, 0); __builtin_amdgcn_s_setprio(0); } while (0)
#define PG8_WAIT_V(n) asm volatile("s_waitcnt vmcnt(" #n ")" ::: "memory")
#define PG8_WAIT_L(n) asm volatile("s_waitcnt lgkmcnt(" #n ")" ::: "memory")
#define PG8_BAR __builtin_amdgcn_s_barrier()
#define PG8_SCHED __builtin_amdgcn_sched_barrier(0)
    Unit cur, nxt; int ui = 0;
    if (!S.next(0, cur)) return;
    f32x4 acc[2][2][4][2];
#pragma unroll
    for (int a = 0; a < 2; ++a)
#pragma unroll
        for (int b = 0; b < 2; ++b)
#pragma unroll
            for (int m = 0; m < 4; ++m)
#pragma unroll
                for (int n = 0; n < 2; ++n) acc[a][b][m][n] = (f32x4){0.f, 0.f, 0.f, 0.f};
    bf16x8 At[4][2], B0[2][2], B1[2][2];
    const char* cA = (const char*)g.A + (size_t)cur.pm * tstepA + (size_t)cur.pn * g.a_pn_off; const char* cB = (const char*)g.Bt + (size_t)cur.pn * tstepB;
    if constexpr (SP2) {
        PG8_STAGE(PG8_SB(0, 0), cB, voffB); PG8_STAGE(PG8_SB(0, 1), cB + hstepB, voffB); PG8_STAGE(PG8_SA(0, 0), cA, voffA); PG8_STAGE(PG8_SA(0, 1), cA + hstepA, voffA);
        if (wr == 1) PG8_BAR;
        PG8_WAIT_V(2); PG8_BAR;
        PG8_STAGE(PG8_SB(1, 0), cB + kstep, voffB); PG8_STAGE(PG8_SA(1, 0), cA + kstep, voffA); PG8_STAGE(PG8_SB(1, 1), cB + hstepB + kstep, voffB);
        PG8_WAIT_V(6); PG8_BAR;
    } else {
        PG8_STAGE(PG8_SB(0, 0), cB, voffB); PG8_STAGE(PG8_SA(0, 0), cA, voffA); PG8_STAGE(PG8_SB(0, 1), cB + hstepB, voffB); PG8_STAGE(PG8_SA(0, 1), cA + hstepA, voffA);
        if (wr == 1) PG8_BAR;
        PG8_WAIT_V(4); PG8_BAR;
        PG8_STAGE(PG8_SB(1, 0), cB + kstep, voffB); PG8_STAGE(PG8_SA(1, 0), cA + kstep, voffA); PG8_STAGE(PG8_SB(1, 1), cB + hstepB + kstep, voffB);
        PG8_WAIT_V(6); PG8_BAR;
    }
    for (;;) {
        const bool has_next = S.next(ui + 1, nxt);
        const char* nA = has_next ? (const char*)g.A + (size_t)nxt.pm * tstepA + (size_t)nxt.pn * g.a_pn_off : cA; const char* nB = has_next ? (const char*)g.Bt + (size_t)nxt.pn * tstepB : cB;
#pragma nounroll
        for (int t = 0; t < nt; t += 2) {
            const bool last = (t == nt - 2);
            const char* a1 = cA + (size_t)(t + 1) * kstep;
            const char* a2 = last ? nA : cA + (size_t)(t + 2) * kstep; const char* b2 = last ? nB : cB + (size_t)(t + 2) * kstep;
            const char* a3 = a2 + kstep; const char* b3 = b2 + kstep;
            if constexpr (SP2) {
            PG8_LDB(B0, 0, 0); PG8_LDB(B1, 0, 1); PG8_SCHED; PG8_LDA(At, 0, 0); PG8_STAGE(PG8_SA(1, 1), a1 + hstepA, voffA);
            PG8_WAIT_V(8); PG8_WAIT_L(0); PG8_BAR; PG8_MMA(0, 0, At, B0); PG8_MMA(0, 1, At, B1); PG8_BAR; PG8_SCHED;
            PG8_LDA(At, 0, 1); PG8_STAGE(PG8_SB(0, 0), b2, voffB); PG8_STAGE(PG8_SB(0, 1), b2 + hstepB, voffB); PG8_STAGE(PG8_SA(0, 0), a2, voffA);
            PG8_WAIT_V(8); PG8_WAIT_L(0); PG8_BAR; PG8_MMA(1, 0, At, B0); PG8_MMA(1, 1, At, B1); PG8_BAR; PG8_SCHED;
            PG8_LDB(B0, 1, 0); PG8_LDB(B1, 1, 1); PG8_SCHED; PG8_LDA(At, 1, 0); PG8_STAGE(PG8_SA(0, 1), a2 + hstepA, voffA);
            PG8_WAIT_V(8); PG8_WAIT_L(0); PG8_BAR; PG8_MMA(0, 0, At, B0); PG8_MMA(0, 1, At, B1); PG8_BAR; PG8_SCHED;
            PG8_LDA(At, 1, 1); PG8_STAGE(PG8_SB(1, 0), b3, voffB); PG8_STAGE(PG8_SB(1, 1), b3 + hstepB, voffB); PG8_STAGE(PG8_SA(1, 0), a3, voffA);
            PG8_WAIT_V(8); PG8_WAIT_L(0); PG8_BAR; PG8_MMA(1, 0, At, B0); PG8_MMA(1, 1, At, B1); PG8_BAR; PG8_SCHED;
            } else {
            PG8_LDB(B0, 0, 0); PG8_SCHED; PG8_LDA(At, 0, 0); PG8_STAGE(PG8_SA(1, 1), a1 + hstepA, voffA);
            PG8_WAIT_L(8); PG8_BAR; PG8_WAIT_L(0); PG8_MMA(0, 0, At, B0); PG8_BAR; PG8_SCHED;
            PG8_LDB(B1, 0, 1); PG8_STAGE(PG8_SB(0, 0), b2, voffB);
            PG8_BAR; PG8_WAIT_L(0); PG8_MMA(0, 1, At, B1); PG8_BAR;
            PG8_LDA(At, 0, 1); PG8_STAGE(PG8_SA(0, 0), a2, voffA);
            PG8_BAR; PG8_WAIT_L(0); PG8_MMA(1, 0, At, B0); PG8_BAR; PG8_SCHED;
            PG8_STAGE(PG8_SB(0, 1), b2 + hstepB, voffB);
            PG8_WAIT_V(6); PG8_BAR; PG8_MMA(1, 1, At, B1); PG8_BAR;
            PG8_LDB(B0, 1, 0); PG8_SCHED; PG8_LDA(At, 1, 0); PG8_STAGE(PG8_SA(0, 1), a2 + hstepA, voffA);
            PG8_WAIT_L(8); PG8_BAR; PG8_WAIT_L(0); PG8_MMA(0, 0, At, B0); PG8_BAR; PG8_SCHED;
            PG8_LDB(B1, 1, 1); PG8_STAGE(PG8_SB(1, 0), b3, voffB);
            PG8_BAR; PG8_WAIT_L(0); PG8_MMA(0, 1, At, B1); PG8_BAR;
            PG8_LDA(At, 1, 1); PG8_STAGE(PG8_SA(1, 0), a3, voffA);
            PG8_BAR; PG8_WAIT_L(0); PG8_MMA(1, 0, At, B0); PG8_BAR; PG8_SCHED;
            PG8_STAGE(PG8_SB(1, 1), b3 + hstepB, voffB);
            PG8_WAIT_V(6); PG8_BAR; PG8_MMA(1, 1, At, B1); PG8_BAR;
            }
        }
        if constexpr (ALIGN_EPI) { if (wr == 0) PG8_BAR; }
        E(acc, cur, wr, wc, fr, fq);
        if (!has_next) break;
#pragma unroll
        for (int a = 0; a < 2; ++a)
#pragma unroll
            for (int b = 0; b < 2; ++b)
#pragma unroll
                for (int m = 0; m < 4; ++m)
#pragma unroll
                    for (int n = 0; n < 2; ++n) acc[a][b][m][n] = (f32x4){0.f, 0.f, 0.f, 0.f};
        cur = nxt; cA = nA; cB = nB; ++ui;
        if constexpr (ALIGN_EPI) { if (wr == 1) PG8_BAR; }
    }
    PG8_WAIT_V(0);
    if constexpr (!ALIGN_EPI) { if (wr == 0) PG8_BAR; }
    PG8_BAR;
#undef PG8_SA
#undef PG8_SB
#undef PG8_STAGE
#undef PG8_LDA
#undef PG8_LDB
#undef PG8_MMA
#undef PG8_WAIT_V
#undef PG8_WAIT_L
#undef PG8_BAR
#undef PG8_SCHED
}
}

namespace fox {
using bf16 = __hip_bfloat16;
constexpr int D = 128;
constexpr float SCALE = 0.08838834764831845f;
constexpr float THR = 8.f;
constexpr int NW = 8, QBLK = 32, KVBLK = 64, QB = NW * QBLK;
constexpr int SHM_V = KVBLK * D * 2, SHM_K = KVBLK * D * 2;
constexpr int OFF_WS = 2 * SHM_V + 2 * SHM_K, OFF_BIAS = OFF_WS + NW * 64 * 4;
constexpr int LDS_BYTES = OFF_BIAS + 2048 * 4;
constexpr int LDQ = QKV_LD, LDO = DM;

#define KSWZ(row, colB) ((row) * 256 + ((colB) ^ (((row) & 7) << 4)))
#define SBAR() __builtin_amdgcn_sched_barrier(0)
__device__ __forceinline__ int v_st(int k, int c) { const int kk = (k & ~0xC) | ((k & 4) << 1) | ((k & 8) >> 1); return ((kk >> 3) * 4 + (c >> 5)) * 512 + ((kk & 7) * 32 + (c & 31)) * 2; }
__device__ __forceinline__ int v_rd_base(int lane) { return ((lane & 3) << 3) | (((lane >> 2) & 3) << 6) | (((lane >> 4) & 1) << 5) | (((lane >> 5) & 1) << 8); }
constexpr int v_rd_off(int d0, int ks, int half) { return d0 * 512 + ks * 4096 + half * 2048; }
__device__ __forceinline__ int crow(int r, int hi) { return (r & 3) + 8 * (r >> 2) + 4 * hi; }
__device__ __forceinline__ unsigned cvtpk(float lo, float hi) { unsigned r; asm volatile("v_cvt_pk_bf16_f32 %0, %1, %2" : "=v"(r) : "v"(lo), "v"(hi)); return r; }
__device__ __forceinline__ bf16x8 load8(const bf16* p) { return *reinterpret_cast<const bf16x8*>(p); }
__device__ __forceinline__ void mask_tile(f32x16& p0, f32x16& p1, int dq, unsigned W) {
    const float NEG = -__builtin_inff();
#pragma unroll
    for (int r = 0; r < 16; ++r) {
        const int c = (r & 3) + 8 * (r >> 2);
        if ((unsigned)(dq - c) >= W) p0[r] = NEG;
        if ((unsigned)(dq - c - 32) >= W) p1[r] = NEG;
    }
}
__device__ __forceinline__ void partialSM(f32x16& p0, f32x16& p1, float& m_reg, float& mn, float& alpha) {
    float pmax = p0[0]; for (int r = 1; r < 16; ++r) pmax = fmaxf(pmax, p0[r]); for (int r = 0; r < 16; ++r) pmax = fmaxf(pmax, p1[r]);
    { auto rr = __builtin_amdgcn_permlane32_swap(__float_as_uint(pmax), __float_as_uint(pmax), false, false);
      pmax = fmaxf(__uint_as_float(rr[0]), __uint_as_float(rr[1])); }
    constexpr float C2 = 1.4426950408889634f * SCALE;
    if (__builtin_expect(__all((pmax - m_reg) * SCALE <= THR), 1)) { mn = m_reg; alpha = 1.f; }
    else { mn = fmaxf(m_reg, pmax); alpha = __builtin_amdgcn_exp2f((m_reg - mn) * C2); m_reg = mn; }
    const float mnL = -mn * C2;
    for (int r = 0; r < 16; ++r) p0[r] = fmaf(p0[r], C2, mnL); for (int r = 0; r < 16; ++r) p1[r] = fmaf(p1[r], C2, mnL);
    for (int r = 0; r < 16; ++r) p0[r] = __builtin_amdgcn_exp2f(p0[r]);
}
__device__ __forceinline__ void finishSM(f32x16& p0, f32x16& p1, float alpha, float& l_reg, bf16x8& pa0, bf16x8& pa1, bf16x8& pa2, bf16x8& pa3) {
    for (int r = 0; r < 16; ++r) p1[r] = __builtin_amdgcn_exp2f(p1[r]);
    float ps = 0; for (int r = 0; r < 16; ++r) ps += p0[r]; for (int r = 0; r < 16; ++r) ps += p1[r];
    { auto rr = __builtin_amdgcn_permlane32_swap(__float_as_uint(ps), __float_as_uint(ps), false, false);
      ps = __uint_as_float(rr[0]) + __uint_as_float(rr[1]); }
    l_reg = l_reg * alpha + ps;
#define PK4(P, B_, OUT) do { unsigned a0 = cvtpk(P[B_+0], P[B_+1]), a1 = cvtpk(P[B_+2], P[B_+3]);                          \
        unsigned b0 = cvtpk(P[B_+4], P[B_+5]), b1 = cvtpk(P[B_+6], P[B_+7]);                                             \
        auto r0 = __builtin_amdgcn_permlane32_swap(a0, b0, false, false); auto r1 = __builtin_amdgcn_permlane32_swap(a1, b1, false, false); \
        u32x4 w = {r0[0], r1[0], r0[1], r1[1]}; OUT = *reinterpret_cast<bf16x8*>(&w); } while (0)
    PK4(p0, 0, pa0); PK4(p0, 8, pa1); PK4(p1, 0, pa2); PK4(p1, 8, pa3);
#undef PK4
}
template <int KB>
__device__ __forceinline__ void qkt(f32x16& p0, f32x16& p1, const char* K_lds, const float* bias_t, int r32, int hi, const bf16x8* qr) {
    const float* bl = bias_t + 4 * hi;
#pragma unroll
    for (int j = 0; j < 4; ++j) { const f32x4 a = *(const f32x4*)(bl + 8 * j), b = *(const f32x4*)(bl + 32 + 8 * j);
#pragma unroll
        for (int e = 0; e < 4; ++e) { p0[4 * j + e] = a[e]; p1[4 * j + e] = b[e]; } }
    const char* kb[4];
#pragma unroll
    for (int dd = 0; dd < 4; ++dd) kb[dd] = K_lds + KB * SHM_K + KSWZ(r32, (dd * 16 + hi * 8) * 2);
#pragma unroll
    for (int d0 = 0; d0 < 8; ++d0) { const char* a = kb[d0 & 3] + (d0 >> 2) * 128;
        bf16x8 b0 = *reinterpret_cast<const bf16x8*>(a);
        bf16x8 b1 = *reinterpret_cast<const bf16x8*>(a + 32 * 256);
        p0 = __builtin_amdgcn_mfma_f32_32x32x16_bf16(b0, qr[d0], p0, 0, 0, 0);
        p1 = __builtin_amdgcn_mfma_f32_32x32x16_bf16(b1, qr[d0], p1, 0, 0, 0); }
}
template <int VB>
__device__ __forceinline__ void pv_tile(f32x16* o, int vb0, bf16x8 pa0, bf16x8 pa1, bf16x8 pa2, bf16x8 pa3) {
#define TRRD(dst, off) asm volatile("ds_read_b64_tr_b16 %0, %1 offset:%2" : "=&v"(dst) : "v"(vb0), "i"(off) : "memory")
#define PV_D0(d0) do { s16x4 l0, l1, l2, l3, h0, h1, h2, h3; constexpr int b_ = VB * SHM_V + v_rd_off(d0, 0, 0); \
        TRRD(l0, b_); TRRD(h0, b_ + 2048); TRRD(l1, b_ + 4096); TRRD(h1, b_ + 6144); TRRD(l2, b_ + 8192); TRRD(h2, b_ + 10240); TRRD(l3, b_ + 12288); TRRD(h3, b_ + 14336); \
        asm volatile("s_waitcnt lgkmcnt(0)" ::: "memory"); SBAR();   \
        o[d0] = __builtin_amdgcn_mfma_f32_32x32x16_bf16(pa0, (bf16x8){l0[0], l0[1], l0[2], l0[3], h0[0], h0[1], h0[2], h0[3]}, o[d0], 0, 0, 0);   \
        o[d0] = __builtin_amdgcn_mfma_f32_32x32x16_bf16(pa1, (bf16x8){l1[0], l1[1], l1[2], l1[3], h1[0], h1[1], h1[2], h1[3]}, o[d0], 0, 0, 0);   \
        o[d0] = __builtin_amdgcn_mfma_f32_32x32x16_bf16(pa2, (bf16x8){l2[0], l2[1], l2[2], l2[3], h2[0], h2[1], h2[2], h2[3]}, o[d0], 0, 0, 0);   \
        o[d0] = __builtin_amdgcn_mfma_f32_32x32x16_bf16(pa3, (bf16x8){l3[0], l3[1], l3[2], l3[3], h3[0], h3[1], h3[2], h3[3]}, o[d0], 0, 0, 0); } while (0)
    PV_D0(0); PV_D0(1); PV_D0(2); PV_D0(3);
#undef PV_D0
#undef TRRD
}
struct BlockRef { const bf16* Q; const bf16* K; const bf16* V; const float* Bias; bf16* O; int P0; };
struct Seam { bf16x8 qr[8]; bf16x8 st_v0, st_v1, st_k0, st_k1; };
#define GROW(p, k0, vo) ((const bf16*)((const char*)((p) + (size_t)(k0) * LDQ) + (vo)))
#define VMW() asm volatile("s_waitcnt vmcnt(0)" ::: "memory")
#define VMWN(n) asm volatile("s_waitcnt vmcnt(%0)" :: "i"(n) : "memory")
#define SLOAD_H(Kp, Vp, Bp, k0) do { S.st_v0 = load8(GROW(Vp, k0, voffk0)); S.st_v1 = load8(GROW(Vp, k0, voffk1));              \
                         S.st_k0 = load8(GROW(Kp, k0, voffk0)); S.st_k1 = load8(GROW(Kp, k0, voffk1)); } while (0)
#define SWRITE_HK(bf) do { *(bf16x8*)(K_lds + (bf) * SHM_K + kws) = S.st_k0; *(bf16x8*)(K_lds + (bf) * SHM_K + kws + 32 * 256) = S.st_k1; } while (0)
#define SWRITE_HV(bf) do { *(bf16x8*)(V_lds + (bf) * SHM_V + vst0) = S.st_v0; *(bf16x8*)(V_lds + (bf) * SHM_V + vst1) = S.st_v1; } while (0)
#define SWRITE_H(bf) do { SWRITE_HV(bf); SWRITE_HK(bf); } while (0)
__device__ __forceinline__ void fox_prime(const BlockRef& cur, char* lds, Seam& S, int wid) {
    asm volatile("" : "+s"(wid));
    int lane = lane_id(); asm volatile("" : "+v"(lane));
    const int tid = wid * 64 + lane, r32 = lane & 31, hi = lane >> 5;
    const int sr = tid >> 4, sc = (tid & 15) * 8, kws = KSWZ(sr, sc * 2); char* K_lds = lds + 2 * SHM_V;
    const unsigned voffk0 = (unsigned)(sr * LDQ + sc) * 2u, voffk1 = voffk0 + 32u * LDQ * 2u, voffq = (unsigned)(r32 * LDQ + hi * 8) * 2u;
    for (int d0 = 0; d0 < 8; ++d0) S.qr[d0] = load8((const bf16*)((const char*)(cur.Q + (size_t)(wid * QBLK) * LDQ) + voffq) + d0 * 16);
    SLOAD_H(cur.K, cur.V, cur.Bias, ((cur.P0 + QB - 1) / KVBLK) * KVBLK); VMW(); SWRITE_HK(0);
    __syncthreads();
}
__device__ __forceinline__ void fox_block(const BlockRef& cur, const BlockRef& nxt, char* lds, Seam& S, int wid) {
    asm volatile("" : "+s"(wid));
    int lane = lane_id(); asm volatile("" : "+v"(lane));
    const int tid = wid * 64 + lane, r32 = lane & 31, hi = lane >> 5;
    constexpr int W = 1 << 30;
    const int NT = (cur.P0 + QB - 1) / KVBLK + 1;
    const int qlo = cur.P0 + wid * QBLK, qm = qlo + r32 - 4 * hi;
    char* V_lds = lds; char* K_lds = lds + 2 * SHM_V; float* bias_lds = (float*)(lds + OFF_BIAS);
    float* ws = (float*)(lds + OFF_WS) + wid * 64; float* li_l = ws, * al_l = ws + 32;
    float m_reg = -1e30f, l_reg = 0; f32x16 o[4] = {};
    const int sr = tid >> 4, sc = (tid & 15) * 8, vst0 = v_st(sr, sc), vst1 = v_st(32 + sr, sc), kws = KSWZ(sr, sc * 2);
    const int vb0 = (int)(uintptr_t)V_lds + v_rd_base(lane);
    const unsigned voffk0 = (unsigned)(sr * LDQ + sc) * 2u, voffk1 = voffk0 + 32u * LDQ * 2u, voffq = (unsigned)(r32 * LDQ + hi * 8) * 2u, voffo = (unsigned)(4 * hi * LDO + r32) * 2u;
    const bf16* Kh = cur.K; const bf16* Vh = cur.V; const float* Bh = cur.Bias;
#define RESC(a) do { if (__any((a) < 1.f)) { if (hi == 0) al_l[r32] = (a); asm volatile("s_waitcnt lgkmcnt(0)" ::: "memory");              \
                     for (int d_ = 0; d_ < 4; ++d_) for (int r = 0; r < 16; ++r) o[d_][r] *= al_l[crow(r, hi)]; } } while (0)
#define KBASE(t) ((NT - 1 - (t)) * KVBLK)
#define MASKT(P0_, P1_, t) do { const int kb_ = KBASE(t); if (kb_ + KVBLK - 1 > qlo) mask_tile(P0_, P1_, qm - kb_, (unsigned)W); } while (0)
    constexpr int NQL = 8;
#define SEAM_K0() do { VMWN(NQL); SWRITE_HK(0); SBAR(); } while (0)
    f32x16 pA0, pA1, pB0, pB1; float mnA, mnB, alA, alB; bf16x8 pa0, pa1, pa2, pa3;
    { if (tid < NT * 16) { const f32x4 bv = *(const f32x4*)(Bh + 4 * tid); *(f32x4*)(bias_lds + 4 * tid) = bv; } __syncthreads(); }
    SWRITE_HV(0); SBAR();
    if (NT > 1) { SLOAD_H(Kh, Vh, Bh, KBASE(1)); }
    SBAR(); qkt<0>(pA0, pA1, K_lds, bias_lds + KBASE(0), r32, hi, S.qr);
    MASKT(pA0, pA1, 0); partialSM(pA0, pA1, m_reg, mnA, alA);
    if (NT > 1) { VMW(); SWRITE_H(1); }
    __syncthreads();
#define HALF_STEP(PX0, PX1, mnX, alX, PY0, PY1, alY, t, KB, VB, SB) do {                                                      \
        SBAR(); qkt<KB>(PX0, PX1, K_lds, bias_lds + KBASE(t), r32, hi, S.qr);                                             \
        finishSM(PY0, PY1, alY, l_reg, pa0, pa1, pa2, pa3); SBAR();                                                           \
        if ((t) + 1 < NT) { SLOAD_H(Kh, Vh, Bh, KBASE((t) + 1)); SBAR(); }                                               \
        pv_tile<VB>(o, vb0, pa0, pa1, pa2, pa3); MASKT(PX0, PX1, (t)); partialSM(PX0, PX1, m_reg, mnX, alX);                                        \
        __syncthreads();                                                                                                      \
        if ((t) + 1 < NT) { VMW(); SWRITE_H(SB); }                                                                          \
        RESC(alX); __syncthreads(); } while (0)
    for (int t = 1; t + 1 < NT; t += 2) {
        HALF_STEP(pB0, pB1, mnB, alB, pA0, pA1, alA, t, 1, 0, 0);
        HALF_STEP(pA0, pA1, mnA, alA, pB0, pB1, alB, t + 1, 0, 1, 1);
    }
    const bool even = (NT & 1) == 0;
    if (even) { SBAR(); qkt<1>(pB0, pB1, K_lds, bias_lds + KBASE(NT - 1), r32, hi, S.qr); SBAR(); }
    SLOAD_H(nxt.K, nxt.V, nxt.Bias, ((nxt.P0 + QB - 1) / KVBLK) * KVBLK); SBAR();
#pragma unroll
    for (int d0 = 0; d0 < 8; ++d0) S.qr[d0] = load8((const bf16*)((const char*)(nxt.Q + (size_t)(wid * QBLK) * LDQ) + voffq) + d0 * 16);
    SBAR();
    finishSM(pA0, pA1, alA, l_reg, pa0, pa1, pa2, pa3); SBAR();
    pv_tile<0>(o, vb0, pa0, pa1, pa2, pa3);
    if (even) { MASKT(pB0, pB1, NT - 1); partialSM(pB0, pB1, m_reg, mnB, alB); __syncthreads(); RESC(alB);
        finishSM(pB0, pB1, alB, l_reg, pa0, pa1, pa2, pa3); SBAR(); pv_tile<1>(o, vb0, pa0, pa1, pa2, pa3); }
    SBAR(); SEAM_K0();
    if (hi == 0) li_l[r32] = l_reg; asm volatile("s_waitcnt lgkmcnt(0)" ::: "memory");
    float rli[16];
#pragma unroll
    for (int r = 0; r < 16; ++r) rli[r] = __builtin_amdgcn_rcpf(li_l[crow(r, hi)]);
    char* Ob = (char*)(cur.O + (size_t)(wid * QBLK) * LDO);
#pragma unroll
    for (int r = 0; r < 16; ++r) { char* Orow = Ob + (size_t)(((r & 3) + 8 * (r >> 2)) * LDO) * 2;
#pragma unroll
        for (int d0 = 0; d0 < 4; ++d0) { const float v = o[d0][r] * rli[r];
            const float vn = __builtin_bit_cast(float, __builtin_amdgcn_mov_dpp(__builtin_bit_cast(int, v), 0xB1, 0xf, 0xf, true));
            if ((r32 & 1) == 0) *(unsigned*)(Orow + voffo + d0 * 64) = cvtpk(v, vn); } }
    __syncthreads();
#undef RESC
#undef KBASE
#undef MASKT
#undef SEAM_K0
#undef HALF_STEP
}
#undef GROW
#undef VMW
#undef VMWN
#undef SLOAD_H
#undef SWRITE_HK
#undef SWRITE_HV
#undef SWRITE_H
#undef SBAR
}

constexpr size_t MiB = 1u << 20;
constexpr size_t WS_WINE = 1 * MiB;
constexpr size_t WS_WOUTE = WS_WINE + 12 * MiB;
constexpr size_t WS_WINO = WS_WOUTE + 8 * MiB;
constexpr size_t WS_WOUTO = WS_WINO + 25 * MiB;
constexpr size_t WS_WUP = WS_WOUTO + 8 * MiB;
constexpr size_t WS_WDOWN = WS_WUP + 88 * MiB;
constexpr size_t WS_WPOOL = WS_WDOWN + 44 * MiB;
constexpr size_t WS_WSP = WS_WPOOL + 512 * 1024;
constexpr size_t WS_SS = WS_WSP + 512 * 1024;
constexpr size_t WS_XB = WS_SS + 1 * MiB;
constexpr size_t WS_SH = WS_XB + 128 * MiB;
constexpr size_t WS_Z = WS_SH;
constexpr size_t WS_MIX = WS_Z + 192 * MiB;
constexpr size_t WS_DP = WS_MIX + 128 * MiB;
constexpr size_t WS_ACT = WS_SH;
constexpr size_t WS_RAW = WS_ACT + 352 * MiB;
constexpr size_t WS_QKV = WS_SH;
constexpr size_t WS_ATT = WS_QKV + 384 * MiB;
constexpr size_t WS_LF = WS_ATT + 128 * MiB;
constexpr size_t WS_CB = WS_LF + 2 * MiB;
constexpr size_t WS_END = WS_CB + 2 * MiB;
static_assert(WS_END <= 1024 * MiB && WS_RAW + 88 * MiB <= WS_END && WS_DP + 64 * MiB <= WS_END, "d_ws map");

#ifndef PHASE_MASK
#define PHASE_MASK 0xffffffffu
#endif
#define PH(n) if constexpr (((PHASE_MASK) >> (n)) & 1u)
constexpr int REP_P0 = 1, REP_P1 = 1, REP_P2 = 1, REP_UP = 1, REP_ATT = 1;
constexpr int NWAVES = 8;
constexpr int LDS_BYTES = 139264;

struct Args { const float* in[19]; float* out; unsigned char* ws; };
#define GAS __attribute__((address_space(1)))
#define CAS __attribute__((address_space(4)))
__device__ __forceinline__ const float* karg_f(int i) {
    const CAS unsigned long long* ka = (const CAS unsigned long long*)__builtin_amdgcn_kernarg_segment_ptr(); asm volatile("" : "+s"(ka));
    return (const float*)(GAS const float*)ka[i];
}
#define IN(i) karg_f(i)

template <int CTRL> __device__ __forceinline__ float dpp_rd(float v) { return __builtin_bit_cast(float, __builtin_amdgcn_mov_dpp(__builtin_bit_cast(int, v), CTRL, 0xf, 0xf, true)); }
__device__ __forceinline__ float wave_sum(float v) {
    v += dpp_rd<0xB1>(v); v += dpp_rd<0x4E>(v); v += dpp_rd<0x141>(v); v += dpp_rd<0x140>(v);
    return rows_sum(v);
}
struct TrItem { const float* W; const float* g; bf16_t* WT; int ldw, nvalid, K, k0, n0src, n0dst; };
__device__ __forceinline__ void tr_load(const TrItem& t, f32x4 (&v)[8], float (&gs)[8], int lane) {
    const int n = t.n0src + 4 * (lane & 7); const bool ok = n < t.nvalid;
#pragma unroll
    for (int i = 0; i < 8; ++i) { const int kk = 8 * i + (lane >> 3);
        v[i] = ok ? *(const f32x4*)(t.W + (size_t)(t.k0 + kk) * t.ldw + n) : (f32x4){0.f, 0.f, 0.f, 0.f};
        gs[i] = t.g ? t.g[t.k0 + kk] : 1.0f; }
}
__device__ __forceinline__ void tr_finish(const TrItem& t, const f32x4 (&v)[8], const float (&gs)[8], LAS float* scr, int lane) {
#pragma unroll
    for (int i = 0; i < 8; ++i) { const int kk = 8 * i + (lane >> 3); LAS float* d = scr + kk * 33 + 4 * (lane & 7);
        d[0] = v[i][0] * gs[i]; d[1] = v[i][1] * gs[i]; d[2] = v[i][2] * gs[i]; d[3] = v[i][3] * gs[i]; }
    asm volatile("s_waitcnt lgkmcnt(0)" ::: "memory");
    const int c = lane & 7;
#pragma unroll
    for (int j = 0; j < 4; ++j) { const int n = (lane >> 3) + 8 * j; const LAS float* s = scr + (8 * c) * 33 + n;
        u32x4 o; o.x = cvt_pk_bf16(s[0 * 33], s[1 * 33]); o.y = cvt_pk_bf16(s[2 * 33], s[3 * 33]); o.z = cvt_pk_bf16(s[4 * 33], s[5 * 33]); o.w = cvt_pk_bf16(s[6 * 33], s[7 * 33]);
        *(u32x4*)(t.WT + (size_t)(t.n0dst + n) * t.K + t.k0 + 8 * c) = o; }
    asm volatile("s_waitcnt lgkmcnt(0)" ::: "memory");
}
#define XB_TMO      128
#define XB_XCNT(j)  (256  + 64 * (j))
#define XB_XSUB(j)  (1280 + 64 * (j))
#define XB_XGEN(j)  (2304 + 64 * (j))
#define XB_TOP      3328
#define XB_TOPGEN   3392
#define XCD_BAR_WORDS 3456
#define XB_SPIN_CAP (1u << 22)
__device__ __forceinline__ unsigned xb_ld(unsigned* p)              { return __hip_atomic_load(p, __ATOMIC_RELAXED, __HIP_MEMORY_SCOPE_AGENT); }
__device__ __forceinline__ unsigned xb_add(unsigned* p, unsigned v) { return __hip_atomic_fetch_add(p, v, __ATOMIC_RELAXED, __HIP_MEMORY_SCOPE_AGENT); }
__device__ __forceinline__ unsigned xb_xcc_id() { return (unsigned)__builtin_amdgcn_s_getreg((3 << 11) | 20) & 0xFu; }
#define XB_SPIN(cond, bar) do { unsigned _sp = 0; while (cond) { __builtin_amdgcn_s_sleep(1); \
    if ((++_sp & 255u) == 0u) { if (xb_ld(&(bar)[XB_TMO])) break; if (_sp > XB_SPIN_CAP) { atomicAdd(&(bar)[XB_TMO], 1u); break; } } } } while (0)
__device__ __forceinline__ void xcd_barrier_complete(unsigned* bar, unsigned x, unsigned& nloc, unsigned& nx) {
    const unsigned G = gridDim.x * gridDim.y * gridDim.z;
    unsigned sum, cnt, mine, sp = 0u;
    for (;;) {
        sum = 0u; cnt = 0u; mine = 0u;
#pragma unroll
        for (unsigned j = 0; j < 16; ++j) { const unsigned c = xb_ld(&bar[XB_XCNT(j)]); sum += c; cnt += (c > 0u) ? 1u : 0u; mine = (j == x) ? c : mine; }
        if (sum == G) break;
        __builtin_amdgcn_s_sleep(1);
        if ((++sp & 255u) == 0u) { if (xb_ld(&bar[XB_TMO])) break; if (sp > XB_SPIN_CAP) { atomicAdd(&bar[XB_TMO], 1u); break; } }
    }
    nloc = mine > 0u ? mine : 1u; nx = cnt > 0u ? cnt : 1u;
}
__device__ __forceinline__ void grid_bar(unsigned* bar, volatile LAS unsigned* st, int wave_s) {
    asm volatile("s_waitcnt vmcnt(0)" ::: "memory");
    __syncthreads();
    if (wave_s == 0) { if (lane_id() == 0) {
        __builtin_amdgcn_s_waitcnt(0);
        const unsigned x = xb_xcc_id();
        unsigned nloc = st[0], nx = st[1];
        if (nloc == 0u) { xcd_barrier_complete(bar, x, nloc, nx); st[0] = nloc; st[1] = nx; }
        const unsigned old = xb_add(&bar[XB_XSUB(x)], 1u);
        const unsigned gen = old / nloc;
        if (old + 1u == (gen + 1u) * nloc) {
            __builtin_amdgcn_fence(__ATOMIC_RELEASE, "agent");
            asm volatile("s_waitcnt vmcnt(0)" ::: "memory");
            const unsigned og = xb_add(&bar[XB_TOP], 1u);
            const unsigned tg = og / nx;
            if (og + 1u == (tg + 1u) * nx) xb_add(&bar[XB_TOPGEN], 1u);
            else XB_SPIN(xb_ld(&bar[XB_TOPGEN]) == tg, bar);
            __builtin_amdgcn_fence(__ATOMIC_ACQUIRE, "agent");
            xb_add(&bar[XB_XGEN(x)], 1u);
            asm volatile("s_waitcnt vmcnt(0)" ::: "memory");
        } else {
            XB_SPIN(xb_ld(&bar[XB_XGEN(x)]) == gen, bar);
            __builtin_amdgcn_fence(__ATOMIC_ACQUIRE, "agent");
            asm volatile("s_waitcnt vmcnt(0)" ::: "memory");
        }
    } }
    __syncthreads();
}
__global__ void __launch_bounds__(NWAVES * 64, 2) mega_fwd(Args args) {
    extern __shared__ __attribute__((aligned(16))) unsigned char lds[];
    cg::grid_group grid = cg::this_grid();
    const int wave_s = __builtin_amdgcn_readfirstlane((int)threadIdx.x >> 6);
#define PHASE_IDS int lane = lane_id(); asm volatile("" : "+v"(lane)); int wave = wave_s; asm volatile("" : "+s"(wave)); const int tid = wave * 64 + lane; (void)tid
    const int G = gridDim.x, bx = blockIdx.x;
    { if (threadIdx.x < 16) ((LAS unsigned*)((LAS unsigned char*)lds + LDS_BYTES - 64))[threadIdx.x] = 0u; __syncthreads();
      if (threadIdx.x == 0) (void)xb_add((unsigned*)karg_f(20) + XB_XCNT(xb_xcc_id()), 1u); }
#define GBAR() grid_bar((unsigned*)karg_f(20), (volatile LAS unsigned*)((LAS unsigned char*)lds + LDS_BYTES - 64), wave_s)
#define WSPTRS unsigned char* ws = (unsigned char*)karg_f(20); const float* x = IN(0); float* R = (float*)karg_f(19); \
    bf16_t* WinE = (bf16_t*)(ws + WS_WINE); bf16_t* WoutE = (bf16_t*)(ws + WS_WOUTE); bf16_t* WinO = (bf16_t*)(ws + WS_WINO); bf16_t* WoutO = (bf16_t*)(ws + WS_WOUTO); \
    bf16_t* Wup = (bf16_t*)(ws + WS_WUP); bf16_t* Wdown = (bf16_t*)(ws + WS_WDOWN); bf16_t* Wpool = (bf16_t*)(ws + WS_WPOOL); bf16_t* Wsp = (bf16_t*)(ws + WS_WSP); \
    float* SS = (float*)(ws + WS_SS); bf16_t* XB = (bf16_t*)(ws + WS_XB); \
    bf16_t* Z = (bf16_t*)(ws + WS_Z); bf16_t* MIX = (bf16_t*)(ws + WS_MIX); bf16_t* DP = (bf16_t*)(ws + WS_DP); \
    bf16_t* ACT = (bf16_t*)(ws + WS_ACT); float* RAW = (float*)(ws + WS_RAW); \
    bf16_t* QKV = (bf16_t*)(ws + WS_QKV); bf16_t* ATT = (bf16_t*)(ws + WS_ATT); float* LF = (float*)(ws + WS_LF); float* CB = (float*)(ws + WS_CB); \
    (void)x; (void)R; (void)WinE; (void)WoutE; (void)WinO; (void)WoutO; (void)Wup; (void)Wdown; (void)Wpool; (void)Wsp; (void)SS; (void)XB; (void)Z; (void)MIX; (void)DP; (void)ACT; (void)RAW; (void)QKV; (void)ATT; (void)LF; (void)CB
    LAS unsigned char* ldsl = (LAS unsigned char*)lds;

    for (int rep_ = 0; rep_ < REP_P0; ++rep_) { if (rep_) GBAR();
    PH(0) {
        PHASE_IDS; WSPTRS;
        LAS float* scr = (LAS float*)(ldsl + wave * 8448);
        const int gw = bx * NWAVES + wave, NGW = G * NWAVES;
        constexpr int I_INE = 32 * 96, I_SQ = 32 * 64, I_POOL = 0, I_INO = 32 * 193, I_UP = 32 * 352, I_DN = 88 * 64;
        constexpr int NITEMS = I_INE + I_SQ + I_POOL + I_INO + I_SQ + 2 * I_UP + 2 * I_DN;
        auto decode = [&](int it) { TrItem t; int r = it;
            if (r < I_INE) { const int kb = r / 96, nb = r % 96; t = TrItem{IN(4), IN(1), WinE, EVEN_IN, EVEN_IN, DM, 64 * kb, 32 * nb, 32 * nb}; return t; } r -= I_INE;
            if (r < I_SQ) { const int kb = r / 64, nb = r % 64; t = TrItem{IN(11), nullptr, WoutE, DM, DM, DM, 64 * kb, 32 * nb, 32 * nb}; return t; } r -= I_SQ;
            if (r < I_POOL) { const int j = r / 32, rr = r % 32, kb = rr / 8, nb = rr % 8; t = TrItem{IN(9) + j * 65536, nullptr, Wpool + j * 65536, 256, 256, 256, 64 * kb, 32 * nb, 32 * nb}; return t; } r -= I_POOL;
            if (r < I_INO) { const int kb = r / 193, nb = r % 193; t = TrItem{IN(12), IN(1) + DM, WinO, ODD_IN, ODD_IN, DM, 64 * kb, 32 * nb, 32 * nb}; return t; } r -= I_INO;
            if (r < I_SQ) { const int kb = r / 64, nb = r % 64; t = TrItem{IN(14), nullptr, WoutO, DM, DM, DM, 64 * kb, 32 * nb, 32 * nb}; return t; } r -= I_SQ;
            if (r < 2 * I_UP) { const int l = r / I_UP, rr = r % I_UP, kb = rr / 352, nb = rr % 352; const int n0 = 32 * nb;
                const int nd = n0 < DFF ? (n0 >> 7) * 256 + (n0 & 127) : ((n0 - DFF) >> 7) * 256 + 128 + ((n0 - DFF) & 127);
                t = TrItem{IN(15) + (size_t)l * DM * NUP, IN(2) + l * DM, Wup + (size_t)l * NUP * DM, NUP, NUP, DM, 64 * kb, n0, nd}; return t; } r -= 2 * I_UP;
            { const int l = r / I_DN, rr = r % I_DN, kb = rr / 64, nb = rr % 64;
                t = TrItem{IN(18) + (size_t)l * DFF * DM, nullptr, Wdown + (size_t)l * DM * DFF, DM, DM, DFF, 64 * kb, 32 * nb, 32 * nb}; return t; } };
        {
            int it = gw; TrItem cur; f32x4 va[8], vb[8]; float ga[8], gb[8];
            if (it < NITEMS) { cur = decode(it); tr_load(cur, va, ga, lane); }
            while (it < NITEMS) {
                const int nit = it + NGW; TrItem nx = cur;
                if (nit < NITEMS) { nx = decode(nit); tr_load(nx, vb, gb, lane); }
                tr_finish(cur, va, ga, scr, lane);
                cur = nx; it = nit;
#pragma unroll
                for (int i = 0; i < 8; ++i) { va[i] = vb[i]; ga[i] = gb[i]; }
            }
        }
        for (int i = bx * 512 + tid; i < 4 * 128 * 128; i += G * 512) { const int t = (i >> 7) & 127, s = i & 127; const float v = ((t >> 6) >= (s >> 6)) ? IN(7)[i] : 0.f; Wsp[i] = (bf16_t)(cvt_pk_bf16(v, 0.f) & 0xffffu); }
        for (int i = bx * 512 + tid; i < 4 * 256 * 256; i += G * 512) { const float v = IN(9)[i] * IN(10)[((i >> 16) << 8) + (i & 255)]; Wpool[i] = (bf16_t)(cvt_pk_bf16(v, 0.f) & 0xffffu); }
        for (int i = bx * 512 + tid; i < 4 * MTOK; i += G * 512) SS[MTOK + i] = 0.f;
        for (int m = gw; m < MTOK; m += 2 * NGW) {
            const int m1 = (m + NGW < MTOK) ? m + NGW : m;
            const f32x4* xr0 = (const f32x4*)(x + (size_t)m * DM) + lane; const f32x4* xr1 = (const f32x4*)(x + (size_t)m1 * DM) + lane; f32x4 v0[8], v1[8]; float s0 = 0.f, s1 = 0.f;
#pragma unroll
            for (int j = 0; j < 8; ++j) { v0[j] = xr0[64 * j]; v1[j] = xr1[64 * j]; }
#pragma unroll
            for (int j = 0; j < 8; ++j) { s0 += (v0[j][0] * v0[j][0] + v0[j][1] * v0[j][1]) + (v0[j][2] * v0[j][2] + v0[j][3] * v0[j][3]); s1 += (v1[j][0] * v1[j][0] + v1[j][1] * v1[j][1]) + (v1[j][2] * v1[j][2] + v1[j][3] * v1[j][3]); }
            s0 = wave_sum(s0); s1 = wave_sum(s1);
            u32x2* o0 = (u32x2*)(XB + (size_t)m * DM) + lane; u32x2* o1 = (u32x2*)(XB + (size_t)m1 * DM) + lane;
#pragma unroll
            for (int j = 0; j < 8; ++j) { u32x2 w; w.x = cvt_pk_bf16(v0[j][0], v0[j][1]); w.y = cvt_pk_bf16(v0[j][2], v0[j][3]); o0[64 * j] = w;
                u32x2 w1; w1.x = cvt_pk_bf16(v1[j][0], v1[j][1]); w1.y = cvt_pk_bf16(v1[j][2], v1[j][3]); o1[64 * j] = w1; }
            if (lane == 0) { SS[m] = s0; SS[m1] = s1; }
        }
    }
    }
    grid.sync();

    for (int rep_ = 0; rep_ < REP_P1; ++rep_) { if (rep_) GBAR();
    PH(1) {
        WSPTRS;
        {
            pg8::Gemm gw_{WoutE + 1024, Wpool, DM, 256, 256, 512}; pg8::StaticOrder Sw; Sw.init(DM, 1024, G, bx);
            pg8::EpiPool Ew{WoutE, DM, 1024, nullptr};
            pg8::gemm_phase<pg8::EpiPool, pg8::StaticOrder, true, true>(ldsl, gw_, Sw, Ew, wave_s);
        }
        pg8::Gemm g{XB, WinE, DM, DM, DM, 0}; pg8::StaticOrder S; S.init(MTOK, EVEN_IN, G, bx);
        pg8::EpiZ<false> E{Z, EVEN_IN, SS, 8, -1, nullptr, nullptr};
        pg8::gemm_phase<pg8::EpiZ<false>, pg8::StaticOrder, true, true>(ldsl, g, S, E, wave_s);
    }
    }
    GBAR();

    for (int rep_ = 0; rep_ < REP_P2; ++rep_) { if (rep_) GBAR();
    PH(2) {
        PHASE_IDS; WSPTRS;
        constexpr int VT_LD = 136, OFF_W = 256 * VT_LD * 2;
        const int fr = lane & 15, fq = lane >> 4;
        for (int unit = bx; unit < 1024; unit += G) {
            const int g = unit & 3, blk = unit >> 2; const int row0 = blk * 128;
            { const int t = tid >> 2, c0 = (tid & 3) * 32;
#pragma unroll
              for (int j = 0; j < 4; ++j) { const u32x4 w = *(const u32x4*)(Wsp + (size_t)g * 16384 + t * 128 + c0 + j * 8); *(LAS u32x4*)(ldsl + OFF_W + (t * VT_LD + c0 + j * 8) * 2) = w; } }
            { const float* lg = IN(5) + g * 256 + 4 * lane; const float* lb = IN(6) + g * 256 + 4 * lane;
              const f32x4 lgv = *(const f32x4*)lg, lbv = *(const f32x4*)lb;
              u32x2 wv[16];
#pragma unroll
              for (int r = 0; r < 16; ++r) wv[r] = *(const u32x2*)(Z + (size_t)(row0 + 16 * wave + r) * EVEN_IN + 1024 + g * 256 + 4 * lane);
#pragma unroll
              for (int pr = 0; pr < 8; ++pr) { const int s = 16 * wave + 2 * pr;
                  const u32x2 w0 = wv[2 * pr], w1 = wv[2 * pr + 1];
                  f32x4 a = (f32x4){bflo(w0.x), bfhi(w0.x), bflo(w0.y), bfhi(w0.y)}, b = (f32x4){bflo(w1.x), bfhi(w1.x), bflo(w1.y), bfhi(w1.y)};
                  const float ma = wave_sum((a[0] + a[1]) + (a[2] + a[3])) * (1.f / 256.f), mb = wave_sum((b[0] + b[1]) + (b[2] + b[3])) * (1.f / 256.f);
                  a = a - ma; b = b - mb;
                  const float va = wave_sum((a[0] * a[0] + a[1] * a[1]) + (a[2] * a[2] + a[3] * a[3])) * (1.f / 256.f), vb = wave_sum((b[0] * b[0] + b[1] * b[1]) + (b[2] * b[2] + b[3] * b[3])) * (1.f / 256.f);
                  const float ra = __builtin_amdgcn_rsqf(va + EPS), rb = __builtin_amdgcn_rsqf(vb + EPS);
                  a = a * ra * lgv + lbv; b = b * rb * lgv + lbv;
#pragma unroll
                  for (int e = 0; e < 4; ++e) *(LAS unsigned*)(ldsl + ((4 * lane + e) * VT_LD + s) * 2) = cvt_pk_bf16(a[e], b[e]);
              } }
            __syncthreads();
            f32x4 acc[8][2];
#pragma unroll
            for (int mt = 0; mt < 8; ++mt) { acc[mt][0] = (f32x4){0.f, 0.f, 0.f, 0.f}; acc[mt][1] = acc[mt][0]; }
#pragma unroll
            for (int ks = 0; ks < 4; ++ks) {
                bf16x8 bfr[2];
#pragma unroll
                for (int nn = 0; nn < 2; ++nn) bfr[nn] = *(const LAS bf16x8*)(ldsl + ((32 * wave + 16 * nn + fr) * VT_LD + 32 * ks + 8 * fq) * 2);
#pragma unroll
                for (int mt = 0; mt < 8; ++mt) { const bf16x8 afr = *(const LAS bf16x8*)(ldsl + OFF_W + ((16 * mt + fr) * VT_LD + 32 * ks + 8 * fq) * 2);
                    acc[mt][0] = __builtin_amdgcn_mfma_f32_16x16x32_bf16(bfr[0], afr, acc[mt][0], 0, 0, 0);
                    acc[mt][1] = __builtin_amdgcn_mfma_f32_16x16x32_bf16(bfr[1], afr, acc[mt][1], 0, 0, 0); }
            }
            u32x2 uwv[8][2]; float biasv[8];
#pragma unroll
            for (int mt = 0; mt < 8; ++mt) { const int t = 16 * mt + fr; biasv[mt] = IN(8)[g * 128 + t];
#pragma unroll
                for (int nn = 0; nn < 2; ++nn) uwv[mt][nn] = *(const u32x2*)(Z + (size_t)(row0 + t) * EVEN_IN + g * 256 + 32 * wave + 16 * nn + 4 * fq); }
            asm volatile("" ::: "memory");
#pragma unroll
            for (int mt = 0; mt < 8; ++mt) { const int t = 16 * mt + fr; const float bias = biasv[mt];
#pragma unroll
                for (int nn = 0; nn < 2; ++nn) { const int d = 32 * wave + 16 * nn + 4 * fq; const size_t row = (size_t)(row0 + t);
                    const u32x2 uw = uwv[mt][nn]; const f32x4 gt = acc[mt][nn] + bias;
                    u32x2 w; w.x = cvt_pk_bf16(bflo(uw.x) * gt[0], bfhi(uw.x) * gt[1]); w.y = cvt_pk_bf16(bflo(uw.y) * gt[2], bfhi(uw.y) * gt[3]);
                    *(u32x2*)(MIX + row * DM + g * 256 + d) = w; } }
            __syncthreads();
        }
        for (int item = bx * 512 + tid; item < 1024 * 128; item += G * 512) {
            const int cc = item & 127, run = item >> 7; const int c0 = cc * 8; const int w = 2 << (c0 >> 8);
            const int rowa = run * 32, pos0 = rowa & (SEQ - 1);
            const bf16_t* P = Z + 2048 + c0; float s[8];
#pragma unroll
            for (int e = 0; e < 8; ++e) s[e] = 0.f;
            for (int j = 1; j <= w; ++j) if (pos0 - j >= 0) { const u32x4 v = *(const u32x4*)(P + (size_t)(rowa - j) * EVEN_IN);
                s[0] += bflo(v.x); s[1] += bfhi(v.x); s[2] += bflo(v.y); s[3] += bfhi(v.y); s[4] += bflo(v.z); s[5] += bfhi(v.z); s[6] += bflo(v.w); s[7] += bfhi(v.w); }
            for (int i0 = 0; i0 < 32; i0 += 8) {
                u32x4 pv[8], qv[8];
#pragma unroll
                for (int j = 0; j < 8; ++j) { const int row = rowa + i0 + j, pos = pos0 + i0 + j;
                    pv[j] = *(const u32x4*)(P + (size_t)row * EVEN_IN);
                    qv[j] = (pos - w >= 0) ? *(const u32x4*)(P + (size_t)(row - w) * EVEN_IN) : (u32x4){0u, 0u, 0u, 0u}; }
#pragma unroll
                for (int j = 0; j < 8; ++j) { const int row = rowa + i0 + j, pos = pos0 + i0 + j;
                    const u32x4 v = pv[j], q = qv[j]; float p[8] = {bflo(v.x), bfhi(v.x), bflo(v.y), bfhi(v.y), bflo(v.z), bfhi(v.z), bflo(v.w), bfhi(v.w)};
                    const float qq[8] = {bflo(q.x), bfhi(q.x), bflo(q.y), bfhi(q.y), bflo(q.z), bfhi(q.z), bflo(q.w), bfhi(q.w)};
#pragma unroll
                    for (int e = 0; e < 8; ++e) s[e] += p[e] - qq[e];
                    const float inv = 1.f / (float)((pos + 1) < w ? (pos + 1) : w);
                    u32x4 o; o.x = cvt_pk_bf16(s[0] * inv - p[0], s[1] * inv - p[1]); o.y = cvt_pk_bf16(s[2] * inv - p[2], s[3] * inv - p[3]);
                    o.z = cvt_pk_bf16(s[4] * inv - p[4], s[5] * inv - p[5]); o.w = cvt_pk_bf16(s[6] * inv - p[6], s[7] * inv - p[7]);
                    *(u32x4*)(MIX + (size_t)row * DM + 1024 + c0) = o; }
            }
        }
    }
    }
    GBAR();

    PH(4) {
        WSPTRS;
        pg8::Gemm g{MIX, WoutE, DM, DM, DM, 0}; pg8::StaticOrder S; S.init(MTOK, DM, G, bx);
        pg8::EpiRes<true> E{nullptr, XB, nullptr, XB, SS + MTOK};
        pg8::gemm_phase<pg8::EpiRes<true>, pg8::StaticOrder, true, true>(ldsl, g, S, E, wave_s);
    }
    GBAR();

#pragma unroll
    for (int layer = 0; layer < 2; ++layer) {
        if (layer == 1) {
            PH(5) {
                WSPTRS;
                pg8::Gemm g{XB, WinO, DM, DM, DM, 0}; pg8::StaticOrder S; S.init(MTOK, QKV_LD, G, bx);
                pg8::EpiZ<false> E{QKV, QKV_LD, SS + 2 * MTOK, 0, -1, nullptr, nullptr};
                pg8::gemm_phase<pg8::EpiZ<false>, pg8::StaticOrder, true, true>(ldsl, g, S, E, wave_s);
                { PHASE_IDS; const int fr = lane & 15, fq = lane >> 4;
                  for (int rb = bx * 128 + wave * 16; rb < MTOK; rb += G * 128) {
                      const bf16_t* ap = XB + (size_t)(rb + fr) * DM + 8 * fq; const bf16_t* bp = WinO + (size_t)(QKV_LD + fr) * DM + 8 * fq;
                      f32x4 acc = (f32x4){0.f, 0.f, 0.f, 0.f};
#pragma unroll 8
                      for (int k = 0; k < DM; k += 32) { const bf16x8 a = *(const bf16x8*)(ap + k), b = *(const bf16x8*)(bp + k);
                          acc = __builtin_amdgcn_mfma_f32_16x16x32_bf16(b, a, acc, 0, 0, 0); }
                      const float rs = __builtin_amdgcn_rsqf((SS + 2 * MTOK)[rb + fr] * (1.0f / DM) + EPS);
                      *(f32x4*)(LF + (size_t)(rb + fr) * 16 + 4 * fq) = acc * rs; } }
            }
            GBAR();
            PH(6) { PHASE_IDS; WSPTRS; if (wave == 0) {
                for (int bh = bx; bh < NB * NHEAD; bh += G) { const int b = bh >> 4, h = bh & 15;
                    const float* src = LF + ((size_t)b * SEQ + 32 * lane) * 16 + h; float v[32]; float run = 0.f; const float bf = IN(13)[h];
#pragma unroll
                    for (int j = 0; j < 32; ++j) { const float xx = src[j * 16] + bf; run += fminf(xx, 0.f) - 0.6931471805599453f * __builtin_amdgcn_logf(1.0f + __builtin_amdgcn_exp2f(-1.4426950408889634f * fabsf(xx))); v[j] = run; }
                    float incl = run;
#pragma unroll
                    for (int o = 1; o < 64; o <<= 1) { const float t = __shfl_up(incl, o); if (lane >= o) incl += t; }
                    const float excl = incl - run; float* dst = CB + (size_t)bh * SEQ + 32 * lane;
#pragma unroll
                    for (int j = 0; j < 32; ++j) dst[j] = -(v[j] + excl) * (1.0f / fox::SCALE);
                }
            } }
            GBAR();
            for (int rep_ = 0; rep_ < REP_ATT; ++rep_) { if (rep_) GBAR();
            PH(7) {
                WSPTRS;
                const int total = NB * NHEAD * 4;
                if (bx < total) {
                    auto mkref = [&](int L, int pass) { const int bh = L >> 2, xq = L & 3; const int qb = pass ? 7 - xq : xq; const int bp = bh >> 4, h = bh & 15; const int b = bp < 8 ? 2 * bp + 1 : 2 * (bp - 8);
                        fox::BlockRef r; const size_t rowb = (size_t)b * SEQ;
                        r.Q = (const fox::bf16*)QKV + (rowb + qb * 256) * QKV_LD + h * HD; r.K = (const fox::bf16*)QKV + rowb * QKV_LD + DM + h * HD; r.V = (const fox::bf16*)QKV + rowb * QKV_LD + 2 * DM + h * HD;
                        r.Bias = CB + (size_t)(b * 16 + h) * SEQ; r.O = (fox::bf16*)ATT + (rowb + qb * 256) * DM + h * HD; r.P0 = qb * 256; return r; };
                    int L = bx, pass = 0; fox::BlockRef cur = mkref(L, 0); fox::Seam S;
                    fox::fox_prime(cur, (char*)lds, S, wave_s);
                    for (;;) {
                        const bool more_pass = pass == 0, more_item = L + G < total, last = !more_pass && !more_item;
                        int Ln = L, passn = pass + 1; if (!more_pass) { passn = 0; Ln = more_item ? L + G : L; }
                        const fox::BlockRef nxt = last ? cur : mkref(Ln, passn);
                        fox::fox_block(cur, nxt, (char*)lds, S, wave_s);
                        if (last) break;
                        cur = nxt; pass = passn; L = Ln;
                    }
                }
            }
            }
            GBAR();
            PH(8) {
                WSPTRS;
                pg8::Gemm g{ATT, WoutO, DM, DM, DM, 0}; pg8::StaticOrder S; S.init(MTOK, DM, G, bx);
                pg8::EpiRes<true> E{nullptr, XB, nullptr, XB, SS + 3 * MTOK};
                pg8::gemm_phase<pg8::EpiRes<true>, pg8::StaticOrder, true, true>(ldsl, g, S, E, wave_s);
            }
            GBAR();
        }
        const float* cw = IN(16) + (size_t)layer * 3 * NUP; const float* cb = IN(17) + (size_t)layer * NUP;
        for (int rep_ = 0; rep_ < REP_UP; ++rep_) { if (rep_) GBAR();
        PH(9) {
            WSPTRS;
            pg8::Gemm g{XB, Wup + (size_t)layer * NUP * DM, DM, DM, DM, 0}; pg8::StaticOrder S; S.init(MTOK, NUP, G, bx);
            pg8::EpiUpConv E{ACT, RAW, SS + (size_t)(layer == 0 ? 1 : 3) * MTOK, cw, cb};
            pg8::gemm_phase<pg8::EpiUpConv, pg8::StaticOrder, true, true>(ldsl, g, S, E, wave_s);
        }
        }
        GBAR();
        PH(10) { PHASE_IDS; WSPTRS; for (int idx = bx * 512 + tid; idx < 512 * (DFF / 4); idx += G * 512) {
            const int sp = idx / (DFF / 4), c = 4 * (idx - sp * (DFF / 4)); const int rc = (c >> 7) * 256 + (c & 127); const bool first = (sp & 31) == 0;
            const float* Rr = RAW + (size_t)sp * 4 * NUP + rc; const float* Rp = Rr - 4 * NUP; const f32x4 z4 = (f32x4){0.f, 0.f, 0.f, 0.f};
            const f32x4 g0 = *(const f32x4*)Rr, g1 = *(const f32x4*)(Rr + NUP), v0 = *(const f32x4*)(Rr + 128), v1 = *(const f32x4*)(Rr + NUP + 128);
            const f32x4 gm1 = first ? z4 : *(const f32x4*)(Rp + 3 * NUP), gm2 = first ? z4 : *(const f32x4*)(Rp + 2 * NUP), vm1 = first ? z4 : *(const f32x4*)(Rp + 3 * NUP + 128), vm2 = first ? z4 : *(const f32x4*)(Rp + 2 * NUP + 128);
            const f32x4 wg0 = *(const f32x4*)(cw + c), wg1 = *(const f32x4*)(cw + NUP + c), wg2 = *(const f32x4*)(cw + 2 * NUP + c), bg = *(const f32x4*)(cb + c);
            const f32x4 wv0 = *(const f32x4*)(cw + DFF + c), wv1 = *(const f32x4*)(cw + NUP + DFF + c), wv2 = *(const f32x4*)(cw + 2 * NUP + DFF + c), bv = *(const f32x4*)(cb + DFF + c);
            const f32x4 cg0 = bg + wg0 * gm2 + wg1 * gm1 + wg2 * g0, cv0 = bv + wv0 * vm2 + wv1 * vm1 + wv2 * v0;
            const f32x4 cg1 = bg + wg0 * gm1 + wg1 * g0 + wg2 * g1, cv1 = bv + wv0 * vm1 + wv1 * v0 + wv2 * v1;
            u32x2 o0, o1;
            o0.x = cvt_pk_bf16(pg8::silu_f(cg0[0]) * cv0[0], pg8::silu_f(cg0[1]) * cv0[1]); o0.y = cvt_pk_bf16(pg8::silu_f(cg0[2]) * cv0[2], pg8::silu_f(cg0[3]) * cv0[3]);
            o1.x = cvt_pk_bf16(pg8::silu_f(cg1[0]) * cv1[0], pg8::silu_f(cg1[1]) * cv1[1]); o1.y = cvt_pk_bf16(pg8::silu_f(cg1[2]) * cv1[2], pg8::silu_f(cg1[3]) * cv1[3]);
            *(u32x2*)(ACT + (size_t)(sp * 64) * DFF + c) = o0; *(u32x2*)(ACT + (size_t)(sp * 64 + 1) * DFF + c) = o1;
        } }
        GBAR();
        PH(11) {
            WSPTRS;
            pg8::Gemm g{ACT, Wdown + (size_t)layer * DM * DFF, DFF, DFF, DFF, 0}; pg8::MirrorOrder S; S.init(MTOK, DM, G, bx);
            pg8::EpiRes<true> E{nullptr, XB, nullptr, XB, SS + (size_t)(layer == 0 ? 2 : 4) * MTOK};
            pg8::gemm_phase<pg8::EpiRes<true>, pg8::MirrorOrder, true, true>(ldsl, g, S, E, wave_s);
        }
        GBAR();
    }
    PH(12) {
        PHASE_IDS; WSPTRS;
        const float* ss4 = SS + 4 * (size_t)MTOK; const float* gf = IN(3);
        const int c4 = tid; const f32x4 gv = ((const f32x4*)gf)[c4];
        for (int rb = bx * 16; rb < MTOK; rb += G * 16) {
            u32x2 v[16]; float rs[16];
#pragma unroll
            for (int j = 0; j < 16; ++j) { v[j] = ((const u32x2*)XB)[(size_t)(rb + j) * 512 + c4]; rs[j] = ss4[rb + j]; }
#pragma unroll
            for (int j = 0; j < 16; ++j) { const float r = __builtin_amdgcn_rsqf(rs[j] * (1.0f / DM) + EPS); const f32x4 xv = (f32x4){bflo(v[j].x), bfhi(v[j].x), bflo(v[j].y), bfhi(v[j].y)};
                ((f32x4*)R)[(size_t)(rb + j) * 512 + c4] = xv * r * gv; }
        }
    }
}

extern "C" void kernel_launch(void* const* d_in, const int* in_sizes, int n_in, void* d_out, int out_size, void* d_ws, size_t ws_size, hipStream_t stream) {
    static int grid = 0;
    if (grid == 0) {
        if (n_in != 19 || out_size != MTOK * DM || ws_size < WS_END) { fprintf(stderr, "kernel_launch: unexpected shapes (n_in %d out %d ws %zu)\n", n_in, out_size, ws_size); grid = -1; return; }
        int dev = 0, cus = 0, per_cu = 0;
        (void)hipGetDevice(&dev); (void)hipDeviceGetAttribute(&cus, hipDeviceAttributeMultiprocessorCount, dev);
        if (hipFuncSetAttribute((const void*)mega_fwd, hipFuncAttributeMaxDynamicSharedMemorySize, LDS_BYTES) != hipSuccess) { fprintf(stderr, "kernel_launch: hipFuncSetAttribute failed\n"); grid = -1; return; }
        if (hipOccupancyMaxActiveBlocksPerMultiprocessor(&per_cu, (const void*)mega_fwd, NWAVES * 64, LDS_BYTES) != hipSuccess || per_cu < 1) { fprintf(stderr, "kernel_launch: occupancy query gave %d\n", per_cu); per_cu = 1; }
        (void)hipGetLastError();
        grid = cus * 1;
    }
    if (grid < 0) return;
    if (hipMemsetAsync(d_ws, 0, 16384, stream) != hipSuccess) { fprintf(stderr, "kernel_launch: memset failed\n"); return; }
    Args a{};
    for (int i = 0; i < 19; ++i) a.in[i] = (const float*)d_in[i];
    a.out = (float*)d_out; a.ws = (unsigned char*)d_ws;
    void* params[] = {&a};
    hipError_t e = hipLaunchCooperativeKernel((const void*)mega_fwd, dim3(grid), dim3(NWAVES * 64), params, LDS_BYTES, stream);
    if (e != hipSuccess) fprintf(stderr, "kernel_launch: cooperative launch failed: %s (grid %d)\n", hipGetErrorString(e), grid);
}
```
